# Optimizing an MI355X kernel written in HIP

```python
import math
import numpy as np
import jax
import jax.numpy as jnp
from jax import lax

D_MODEL = 2048
BATCH = 4
SEQ = 2048
DEPTH = 2

HEAD_DIM = 128
ROPE_THETA = 500000.0
ROPE_FRACTION = 4
Q_BLOCK = 128
EPS = 1e-6
NEG_INF = -1e30

DA_HEADS = 4
DA_QK_DIM = 64
DA_V_DIM = 2 * DA_QK_DIM

NSA_HEADS = 8
NSA_GROUPS = 2
NSA_HPG = NSA_HEADS // NSA_GROUPS
NSA_BLOCK = 64
NSA_TOP_N = 8
NSA_WINDOW = 512
NSA_FORCED_SCORE = 1e4

FOX_HEADS = 4
FOX_BIAS_INIT = 3.0

D_FF = 256 * ((8 * D_MODEL // 3 + 255) // 256)

DA_QK_COLS = DA_HEADS * 2 * DA_QK_DIM
DA_V_COLS = DA_HEADS * DA_V_DIM
NSA_Q_COLS = NSA_HEADS * HEAD_DIM
NSA_KV_COLS = 3 * 2 * NSA_GROUPS * HEAD_DIM
NSA_GATE_COLS = 3 * NSA_HEADS
FOX_COLS = FOX_HEADS * HEAD_DIM
MERGE_COLS = 3 * D_MODEL
IN_COLS = 2 * DA_QK_COLS + DA_V_COLS + NSA_Q_COLS + NSA_KV_COLS + NSA_GATE_COLS + 3 * FOX_COLS + FOX_HEADS + MERGE_COLS

kernel_name = 'hybrid_diff_nsa_fox_macaron'


def rms_norm(x, gain):
    xf = x.astype(jnp.float32)
    y = xf * lax.rsqrt(jnp.mean(xf * xf, axis=-1, keepdims=True) + EPS)
    return (y * gain.astype(jnp.float32)).astype(x.dtype)


def rope_cos_sin(positions, rot_dim):
    inv_freq = ROPE_THETA ** (-jnp.arange(0, rot_dim, 2, dtype=jnp.float32) / rot_dim)
    ang = positions.astype(jnp.float32)[..., None] * inv_freq
    return jnp.cos(ang)[:, :, None, :], jnp.sin(ang)[:, :, None, :]


def partial_rope(x, cos, sin):
    half = cos.shape[-1]
    xf = x.astype(jnp.float32)
    x1 = xf[..., :half]
    x2 = xf[..., half:2 * half]
    out = jnp.concatenate([x1 * cos - x2 * sin, x2 * cos + x1 * sin, xf[..., 2 * half:]], axis=-1)
    return out.astype(x.dtype)


def masked_softmax(s, mask):
    return jax.nn.softmax(jnp.where(mask, s.astype(jnp.float32), NEG_INF), axis=-1)


def causal_mask(lo, n, hi):
    return (lo + jnp.arange(n))[:, None] >= jnp.arange(hi)[None, :]


def swiglu(h, w_gate, w_up, w_down):
    return (jax.nn.silu(h @ w_gate) * (h @ w_up)) @ w_down


def diff_attention(q, k, v, lam, out_gain, lam_init):
    B, S, H, _, dq = q.shape
    scale = dq ** -0.5
    outs = []
    for c in range(S // Q_BLOCK):
        lo, hi = c * Q_BLOCK, (c + 1) * Q_BLOCK
        s = jnp.einsum('bqhmd,bkhmd->bhmqk', q[:, lo:hi], k[:, :hi]).astype(jnp.float32) * scale
        p = masked_softmax(s, causal_mask(lo, Q_BLOCK, hi))
        w = p[:, :, 0] - lam * p[:, :, 1]
        outs.append(jnp.einsum('bhqk,bkhd->bqhd', w.astype(v.dtype), v[:, :hi]))
    o = jnp.concatenate(outs, axis=1)
    o = rms_norm(o, out_gain) * (1.0 - lam_init)
    return o.reshape(B, S, H * o.shape[-1])


def forgetting_attention(q, k, v, log_f):
    B, S, H, d = q.shape
    scale = d ** -0.5
    cum = jnp.cumsum(log_f, axis=1).transpose(0, 2, 1)
    outs = []
    for c in range(S // Q_BLOCK):
        lo, hi = c * Q_BLOCK, (c + 1) * Q_BLOCK
        s = jnp.einsum('bqhd,bkhd->bhqk', q[:, lo:hi], k[:, :hi]).astype(jnp.float32) * scale
        s = s + cum[:, :, lo:hi, None] - cum[:, :, None, :hi]
        p = masked_softmax(s, causal_mask(lo, Q_BLOCK, hi))
        outs.append(jnp.einsum('bhqk,bkhd->bqhd', p.astype(v.dtype), v[:, :hi]))
    return jnp.concatenate(outs, axis=1).reshape(B, S, H * d)


def nsa_attention(q, k_c, v_c, k_s, v_s, k_w, v_w, gates, cmp_pos, cmp_w1, cmp_w2, k_cmp_gain):
    B, S, G, Hg, d = q.shape
    L = NSA_BLOCK
    NB = S // L
    W = NSA_WINDOW
    n_sel = min(NSA_TOP_N, NB)
    scale = d ** -0.5
    t = jnp.arange(S)

    def compress(tok, pos, w1, w2):
        blk = tok.reshape(B, NB, L, G, d) + pos[None, None, :, None, :]
        blk = blk.transpose(0, 1, 3, 2, 4).reshape(B, NB, G, L * d)
        return jax.nn.gelu(blk @ w1) @ w2

    kc = rms_norm(compress(k_c, cmp_pos[0], cmp_w1[0], cmp_w2[0]), k_cmp_gain)
    vc = compress(v_c, cmp_pos[1], cmp_w1[1], cmp_w2[1])
    blk_end = jnp.arange(NB) * L + L - 1
    cmp_mask = blk_end[None, :] <= t[:, None]
    s_c = jnp.einsum('bsghd,bngd->bsghn', q, kc).astype(jnp.float32) * scale
    p_c = masked_softmax(s_c, cmp_mask[:, None, None, :]) * cmp_mask[:, None, None, :]
    o_cmp = jnp.einsum('bsghn,bngd->bsghd', p_c.astype(vc.dtype), vc)

    importance = p_c.sum(axis=3)
    blk = jnp.arange(NB)[None, :]
    cur = (t // L)[:, None]
    valid = blk <= cur
    forced = (blk == 0) | (blk == cur) | (blk == cur - 1)
    score = jnp.where(forced[:, None, :], NSA_FORCED_SCORE,
                      jnp.where(valid[:, None, :], importance, -1.0))
    _, sel = lax.top_k(score, n_sel)

    ks_blk = k_s.reshape(B, NB, L, G, d).transpose(0, 3, 1, 2, 4)
    vs_blk = v_s.reshape(B, NB, L, G, d).transpose(0, 3, 1, 2, 4)
    gather = jax.vmap(jax.vmap(lambda table, i: table[i]))
    kw_pad = jnp.pad(k_w, ((0, 0), (W, 0), (0, 0), (0, 0)))
    vw_pad = jnp.pad(v_w, ((0, 0), (W, 0), (0, 0), (0, 0)))

    def chunk(c):
        lo = c * Q_BLOCK
        tq = lo + jnp.arange(Q_BLOCK)
        qc = lax.dynamic_slice_in_dim(q, lo, Q_BLOCK, axis=1)
        idx = lax.dynamic_slice_in_dim(sel, lo, Q_BLOCK, axis=1).transpose(0, 2, 1, 3)
        kg = gather(ks_blk, idx)
        vg = gather(vs_blk, idx)
        s_s = jnp.einsum('bqghd,bgqnld->bqghnl', qc, kg).astype(jnp.float32) * scale
        tok = idx[..., None] * L + jnp.arange(L)
        m_s = (tok <= tq[None, None, :, None, None]).transpose(0, 2, 1, 3, 4)
        p_s = masked_softmax(s_s.reshape(B, Q_BLOCK, G, Hg, n_sel * L),
                             m_s.reshape(B, Q_BLOCK, G, 1, n_sel * L))
        p_s = p_s.reshape(B, Q_BLOCK, G, Hg, n_sel, L)
        o_s = jnp.einsum('bqghnl,bgqnld->bqghd', p_s.astype(vg.dtype), vg)
        kwc = lax.dynamic_slice_in_dim(kw_pad, lo, W + Q_BLOCK, axis=1)
        vwc = lax.dynamic_slice_in_dim(vw_pad, lo, W + Q_BLOCK, axis=1)
        kpos = lo - W + jnp.arange(W + Q_BLOCK)
        m_w = ((kpos[None, :] <= tq[:, None]) & (kpos[None, :] > tq[:, None] - W)
               & (kpos[None, :] >= 0))
        s_w = jnp.einsum('bqghd,bkgd->bqghk', qc, kwc).astype(jnp.float32) * scale
        p_w = masked_softmax(s_w, m_w[:, None, None, :])
        o_w = jnp.einsum('bqghk,bkgd->bqghd', p_w.astype(vwc.dtype), vwc)
        return o_s, o_w

    o_s, o_w = lax.map(chunk, jnp.arange(S // Q_BLOCK))
    o_s = jnp.moveaxis(o_s, 0, 1).reshape(B, S, G, Hg, d)
    o_w = jnp.moveaxis(o_w, 0, 1).reshape(B, S, G, Hg, d)
    o = gates[..., 0:1] * o_cmp + gates[..., 1:2] * o_s + gates[..., 2:3] * o_w
    return o.reshape(B, S, G * Hg * d)


def token_mixer(h, cos_a, sin_a, cos_b, sin_b, lam_init, w_in, da_q_norm, da_k_norm, da_lambda,
                da_out_norm, nsa_q_norm, nsa_k_norm, nsa_cmp_pos, nsa_cmp_w1, nsa_cmp_w2,
                fox_q_norm, fox_k_norm, fox_f_bias, w_branch_a, w_branch_b, w_branch_c, w_out):
    B, S, _ = h.shape
    widths = [DA_QK_COLS, DA_QK_COLS, DA_V_COLS, NSA_Q_COLS, NSA_KV_COLS, NSA_GATE_COLS,
              FOX_COLS, FOX_COLS, FOX_COLS, FOX_HEADS, MERGE_COLS]
    (a_q, a_k, a_v, b_q, b_kv, b_g, c_q, c_k, c_v, c_f, g_m) = jnp.split(
        h @ w_in, np.cumsum(widths)[:-1].tolist(), axis=-1)

    qa = partial_rope(rms_norm(a_q.reshape(B, S, 2 * DA_HEADS, DA_QK_DIM), da_q_norm), cos_a, sin_a)
    ka = partial_rope(rms_norm(a_k.reshape(B, S, 2 * DA_HEADS, DA_QK_DIM), da_k_norm), cos_a, sin_a)
    qa = qa.reshape(B, S, DA_HEADS, 2, DA_QK_DIM)
    ka = ka.reshape(B, S, DA_HEADS, 2, DA_QK_DIM)
    va = a_v.reshape(B, S, DA_HEADS, DA_V_DIM)
    lp = da_lambda.astype(jnp.float32)
    lam = jnp.exp(jnp.sum(lp[0] * lp[1])) - jnp.exp(jnp.sum(lp[2] * lp[3])) + lam_init
    o_a = diff_attention(qa, ka, va, lam, da_out_norm, lam_init)

    qb = partial_rope(rms_norm(b_q.reshape(B, S, NSA_HEADS, HEAD_DIM), nsa_q_norm), cos_b, sin_b)
    qb = qb.reshape(B, S, NSA_GROUPS, NSA_HPG, HEAD_DIM)
    kv = b_kv.reshape(B, S, 3, 2, NSA_GROUPS, HEAD_DIM)
    k_cmp = partial_rope(kv[:, :, 0, 0], cos_b, sin_b)
    k_slc = partial_rope(rms_norm(kv[:, :, 1, 0], nsa_k_norm[1]), cos_b, sin_b)
    k_win = partial_rope(rms_norm(kv[:, :, 2, 0], nsa_k_norm[2]), cos_b, sin_b)
    gates = jax.nn.sigmoid(b_g.reshape(B, S, NSA_GROUPS, NSA_HPG, 3))
    o_b = nsa_attention(qb, k_cmp, kv[:, :, 0, 1], k_slc, kv[:, :, 1, 1], k_win, kv[:, :, 2, 1],
                        gates, nsa_cmp_pos, nsa_cmp_w1, nsa_cmp_w2, nsa_k_norm[0])

    qc = rms_norm(c_q.reshape(B, S, FOX_HEADS, HEAD_DIM), fox_q_norm)
    kc = rms_norm(c_k.reshape(B, S, FOX_HEADS, HEAD_DIM), fox_k_norm)
    vc = c_v.reshape(B, S, FOX_HEADS, HEAD_DIM)
    log_f = jax.nn.log_sigmoid(c_f.astype(jnp.float32) + fox_f_bias.astype(jnp.float32))
    o_c = forgetting_attention(qc, kc, vc, log_f)

    gm = jax.nn.sigmoid(g_m).reshape(B, S, 3, D_MODEL)
    y = (gm[:, :, 0] * (o_a @ w_branch_a) + gm[:, :, 1] * (o_b @ w_branch_b)
         + gm[:, :, 2] * (o_c @ w_branch_c))
    return y @ w_out


def setup_inputs(seed: int = 0) -> dict:
    key = jax.random.key(seed)
    keys = iter(jax.random.split(key, 40))

    def nrm(shape, scale):
        return jax.random.normal(next(keys), shape, jnp.float32) * scale

    def gain(shape):
        return 1.0 + nrm(shape, 0.02)

    D, F, L, d = D_MODEL, D_FF, NSA_BLOCK, HEAD_DIM
    x = jax.random.normal(next(keys), (BATCH, SEQ, D), jnp.float32)
    offsets = jax.random.randint(next(keys), (BATCH, 1), 0, 1024)
    positions = (jnp.arange(SEQ)[None, :] + offsets).astype(jnp.int32)
    return {
        'x': x,
        'positions': positions,
        'ffn1_norm': gain((DEPTH, D)),
        'ffn1_w_gate': nrm((DEPTH, D, F), D ** -0.5),
        'ffn1_w_up': nrm((DEPTH, D, F), D ** -0.5),
        'ffn1_w_down': nrm((DEPTH, F, D), F ** -0.5),
        'mix_norm': gain((DEPTH, D)),
        'w_in': nrm((DEPTH, D, IN_COLS), D ** -0.5),
        'da_q_norm': gain((DEPTH, DA_QK_DIM)),
        'da_k_norm': gain((DEPTH, DA_QK_DIM)),
        'da_lambda': nrm((DEPTH, 4, DA_QK_DIM), 0.1),
        'da_out_norm': gain((DEPTH, DA_V_DIM)),
        'nsa_q_norm': gain((DEPTH, d)),
        'nsa_k_norm': gain((DEPTH, 3, d)),
        'nsa_cmp_pos': nrm((DEPTH, 2, L, d), 0.02),
        'nsa_cmp_w1': nrm((DEPTH, 2, L * d, d), (L * d) ** -0.5),
        'nsa_cmp_w2': nrm((DEPTH, 2, d, d), d ** -0.5),
        'fox_q_norm': gain((DEPTH, d)),
        'fox_k_norm': gain((DEPTH, d)),
        'fox_f_bias': FOX_BIAS_INIT + nrm((DEPTH, FOX_HEADS), 0.5),
        'w_branch_a': nrm((DEPTH, DA_V_COLS, D), DA_V_COLS ** -0.5),
        'w_branch_b': nrm((DEPTH, NSA_Q_COLS, D), NSA_Q_COLS ** -0.5),
        'w_branch_c': nrm((DEPTH, FOX_COLS, D), FOX_COLS ** -0.5),
        'w_out': nrm((DEPTH, D, D), D ** -0.5),
        'ffn2_norm': gain((DEPTH, D)),
        'ffn2_w_gate': nrm((DEPTH, D, F), D ** -0.5),
        'ffn2_w_up': nrm((DEPTH, D, F), D ** -0.5),
        'ffn2_w_down': nrm((DEPTH, F, D), F ** -0.5),
    }


def reference(x, positions, ffn1_norm, ffn1_w_gate, ffn1_w_up, ffn1_w_down, mix_norm, w_in,
              da_q_norm, da_k_norm, da_lambda, da_out_norm, nsa_q_norm, nsa_k_norm, nsa_cmp_pos,
              nsa_cmp_w1, nsa_cmp_w2, fox_q_norm, fox_k_norm, fox_f_bias, w_branch_a, w_branch_b,
              w_branch_c, w_out, ffn2_norm, ffn2_w_gate, ffn2_w_up, ffn2_w_down):
    cos_a, sin_a = rope_cos_sin(positions, DA_QK_DIM // ROPE_FRACTION)
    cos_b, sin_b = rope_cos_sin(positions, HEAD_DIM // ROPE_FRACTION)
    for l in range(DEPTH):
        lam_init = 0.8 - 0.6 * math.exp(-0.3 * l)
        x = x + 0.5 * swiglu(rms_norm(x, ffn1_norm[l]), ffn1_w_gate[l], ffn1_w_up[l], ffn1_w_down[l])
        x = x + token_mixer(rms_norm(x, mix_norm[l]), cos_a, sin_a, cos_b, sin_b, lam_init, w_in[l],
                            da_q_norm[l], da_k_norm[l], da_lambda[l], da_out_norm[l],
                            nsa_q_norm[l], nsa_k_norm[l], nsa_cmp_pos[l], nsa_cmp_w1[l], nsa_cmp_w2[l],
                            fox_q_norm[l], fox_k_norm[l], fox_f_bias[l],
                            w_branch_a[l], w_branch_b[l], w_branch_c[l], w_out[l])
        x = x + 0.5 * swiglu(rms_norm(x, ffn2_norm[l]), ffn2_w_gate[l], ffn2_w_up[l], ffn2_w_down[l])
    return x
```

```cpp
#include <hip/hip_runtime.h>
#include <hip/hip_bf16.h>
#include <hip/hip_cooperative_groups.h>
#include <cstdio>
#include <cstdint>
namespace cg = cooperative_groups;
namespace pg8 {
#define PG8_LAS __attribute__((address_space(3)))
typedef unsigned short bf16_t;
typedef short bf16x8 __attribute__((ext_vector_type(8)));
typedef float f32x4 __attribute__((ext_vector_type(4)));
typedef unsigned u32x4 __attribute__((ext_vector_type(4)));
constexpr int BM = 256, BK = 64, HALF = 128, HTB = HALF * BK * 2  , STAGE_BYTES = 8 * HTB, NXCD = 8, WGM = 4;

__host__ __device__ __forceinline__ int lds_byte(int r, int c) { const int st = (r >> 4) * 2 + (c >> 5), rr = r & 15, cc = c & 31, ob = rr * 64 + cc * 2; return st * 1024 + (ob ^ (((ob >> 9) & 1) << 5)); }
__host__ __device__ __forceinline__ void stage_rc(int b, int& R, int& C) { const int st = b / 1024, sb = b % 1024, swz = sb ^ (((sb >> 9) & 1) << 5); R = (st >> 1) * 16 + swz / 64; C = (st & 1) * 32 + (swz % 64) / 2; }
__host__ __device__ __forceinline__ int perm32(int rho) { const int n = rho >> 4, i = rho & 15; return 8 * (i >> 2) + 4 * n + (i & 3); }

struct Unit { int pm, pn; };
struct Gemm { const bf16_t* A; const bf16_t* Bt; int M, N, K; };

struct StaticOrder {
    int nM, nN, nwg, G, c;
    __host__ __device__ void init(int M, int N, int G_, int c_) { nM = M / BM; nN = N / BM; nwg = nM * nN; G = G_; c = c_; }
    __host__ __device__ bool next(int i, Unit& u) const {
        const long L = (long)i * G + c; if (L >= nwg) return false;
        int wgid = (int)L; { const int q = nwg / NXCD, r = nwg % NXCD, xcd = wgid % NXCD, off = wgid / NXCD; wgid = (xcd < r ? xcd * (q + 1) : r * (q + 1) + (xcd - r) * q) + off; }
        const int nig = WGM * nN, gid = wgid / nig, fm = gid * WGM, gsz = (nM - fm) < WGM ? (nM - fm) : WGM;
        u.pm = fm + ((wgid % nig) % gsz); u.pn = (wgid % nig) / gsz; return true;
    }
    __device__ __forceinline__ void a_ready(const Unit&) const {}
    __device__ __forceinline__ void done(const Unit&) const {}
};

__device__ __forceinline__ unsigned cvt_pk_bf16(float lo, float hi) { unsigned r; asm volatile("v_cvt_pk_bf16_f32 %0, %1, %2" : "=v"(r) : "v"(lo), "v"(hi)); return r; }
typedef unsigned u32x2 __attribute__((ext_vector_type(2)));
__device__ __forceinline__ float sigmoidf_(float v) { return __builtin_amdgcn_rcpf(1.f + __expf(-v)); }
__device__ __forceinline__ float bf2f(unsigned short h) { return __uint_as_float(((unsigned)h) << 16); }
struct EpiGU {
    static constexpr bool PERM = true, AFTER_DRAIN = false, HOOK = false;
    bf16_t* O; int ldc; const unsigned long long* rss;
    __device__ __forceinline__ void operator()(const f32x4 (&acc)[2][2][4][2], const Unit& u, int wr, int wc, int fr, int fq) const {
        const int row0 = u.pm * BM + wr * 64 + fr, col0 = u.pn * HALF + wc * 32 + 8 * fq;
#pragma unroll
        for (int ai = 0; ai < 2; ++ai)
#pragma unroll
            for (int m = 0; m < 4; ++m) { bf16_t* rowp = O + (size_t)(row0 + ai * HALF + m * 16) * ldc + col0;
                const float rs = rsqrtf((float)rss[row0 + ai * HALF + m * 16] * (1.f / (65536.f * 2048.f)) + 1e-6f);
                float r[8];
#pragma unroll
                for (int n = 0; n < 2; ++n)
#pragma unroll
                    for (int j = 0; j < 4; ++j) { const float g = acc[ai][0][m][n][j] * rs, uu = acc[ai][1][m][n][j] * rs; r[n * 4 + j] = g * sigmoidf_(g) * uu; }
                u32x4 w; w.x = cvt_pk_bf16(r[0], r[1]); w.y = cvt_pk_bf16(r[2], r[3]); w.z = cvt_pk_bf16(r[4], r[5]); w.w = cvt_pk_bf16(r[6], r[7]);
                *(u32x4*)rowp = w; }
    }
};
struct EpiP {
    static constexpr bool PERM = true, AFTER_DRAIN = false, HOOK = false;
    bf16_t* O; int ldc; const unsigned long long* rss;
    __device__ __forceinline__ void operator()(const f32x4 (&acc)[2][2][4][2], const Unit& u, int wr, int wc, int fr, int fq) const {
        const int row0 = u.pm * BM + wr * 64 + fr, col0 = u.pn * BM + wc * 32 + 8 * fq;
#pragma unroll
        for (int ai = 0; ai < 2; ++ai)
#pragma unroll
            for (int m = 0; m < 4; ++m) { bf16_t* rowp = O + (size_t)(row0 + ai * HALF + m * 16) * ldc + col0;
                const float rs = rsqrtf((float)rss[row0 + ai * HALF + m * 16] * (1.f / (65536.f * 2048.f)) + 1e-6f);
#pragma unroll
                for (int bj = 0; bj < 2; ++bj) { const f32x4 v0 = acc[ai][bj][m][0] * rs, v1 = acc[ai][bj][m][1] * rs;
                    u32x4 w; w.x = cvt_pk_bf16(v0[0], v0[1]); w.y = cvt_pk_bf16(v0[2], v0[3]); w.z = cvt_pk_bf16(v1[0], v1[1]); w.w = cvt_pk_bf16(v1[2], v1[3]);
                    *(u32x4*)(rowp + bj * HALF) = w; } }
    }
};
template <int HALFA> struct EpiRes {
    static constexpr bool PERM = false, AFTER_DRAIN = false, HOOK = false;
    const float* src; float* out; const float* gain; bf16_t* hn; unsigned long long* rss;
    __device__ __forceinline__ void operator()(const f32x4 (&acc)[2][2][4][2], const Unit& u, int wr, int wc, int fr, int fq) const {
        constexpr int ldc = 2048; constexpr float alpha = HALFA ? 0.5f : 1.f;
        int row0 = u.pm * BM + wr * 64 + fr, col0 = u.pn * BM + wc * 32 + 4 * fq; asm volatile("" : "+v"(row0), "+v"(col0));
        const int lane = fq * 16 + fr;
#pragma unroll
        for (int ai = 0; ai < 2; ++ai)
#pragma unroll
            for (int m = 0; m < 4; ++m) { const int row = row0 + ai * HALF + m * 16; const size_t off = (size_t)row * ldc + col0; float ss = 0.f;
#pragma unroll
                for (int bj = 0; bj < 2; ++bj)
#pragma unroll
                    for (int n = 0; n < 2; ++n) { const int co = bj * HALF + n * 16; const f32x4 s = *(const f32x4*)(src + off + co);
                        const f32x4 v = s + acc[ai][bj][m][n] * alpha;
                        *(f32x4*)(out + off + co) = v;
                        const f32x4 g = *(const f32x4*)(gain + col0 + co);
                        u32x2 w; w.x = cvt_pk_bf16(v[0] * g[0], v[1] * g[1]); w.y = cvt_pk_bf16(v[2] * g[2], v[3] * g[3]); *(u32x2*)(hn + off + co) = w;
                        ss += (v[0] * v[0] + v[1] * v[1]) + (v[2] * v[2] + v[3] * v[3]); }
                ss += __int_as_float(__builtin_amdgcn_ds_bpermute((lane ^ 16) << 2, __float_as_int(ss)));
                ss += __int_as_float(__builtin_amdgcn_ds_bpermute((lane ^ 32) << 2, __float_as_int(ss)));
                if (fq == 0) __hip_atomic_fetch_add(rss + row, (unsigned long long)(unsigned)(ss * 65536.f + 0.5f), __ATOMIC_RELAXED, __HIP_MEMORY_SCOPE_AGENT);
                if (m == 3) asm volatile("" ::: "memory"); }
    }
};
template <int I> struct EpiMerge {
    static constexpr bool PERM = false, AFTER_DRAIN = false, HOOK = false;
    const bf16_t* G; int ldg; int gcol; float* yacc; bf16_t* ybf; int ldc;
    __device__ __forceinline__ void operator()(const f32x4 (&acc)[2][2][4][2], const Unit& u, int wr, int wc, int fr, int fq) const {
        const int row0 = u.pm * BM + wr * 64 + fr, col0 = u.pn * BM + wc * 32 + 4 * fq;
#pragma unroll
        for (int ai = 0; ai < 2; ++ai)
#pragma unroll
            for (int m = 0; m < 4; ++m) { const int row = row0 + ai * HALF + m * 16; const size_t off = (size_t)row * ldc + col0; const bf16_t* gp = G + (size_t)row * ldg + gcol + col0;
#pragma unroll
                for (int bj = 0; bj < 2; ++bj)
#pragma unroll
                    for (int n = 0; n < 2; ++n) { const int co = bj * HALF + n * 16;
                        const u32x2 gw = *(const u32x2*)(gp + co);
                        f32x4 gt; gt[0] = sigmoidf_(__uint_as_float(gw.x << 16)); gt[1] = sigmoidf_(__uint_as_float(gw.x & 0xffff0000u));
                        gt[2] = sigmoidf_(__uint_as_float(gw.y << 16)); gt[3] = sigmoidf_(__uint_as_float(gw.y & 0xffff0000u));
                        f32x4 v = gt * acc[ai][bj][m][n];
                        if (I > 0) v += *(const f32x4*)(yacc + off + co);
                        if (I < 2) *(f32x4*)(yacc + off + co) = v;
                        else { u32x2 w; w.x = cvt_pk_bf16(v[0], v[1]); w.y = cvt_pk_bf16(v[2], v[3]); *(u32x2*)(ybf + off + co) = w; } }
                asm volatile("" ::: "memory"); }
    }
};

struct EpiMergeH {
    static constexpr bool PERM = false, AFTER_DRAIN = false, HOOK = true;
    const bf16_t* G; int ldg; int gcol; bf16_t* ybf; int ldc;
    __device__ __forceinline__ void hook(f32x4 (&acc)[2][2][4][2], const Unit& u, int wr, int wc, int fr, int fq, int which) const {
        int row0 = u.pm * BM + wr * 64 + fr, col0 = u.pn * BM + wc * 32 + 4 * fq; asm volatile("" : "+v"(row0), "+v"(col0));
#pragma unroll
        for (int ai = 0; ai < 2; ++ai)
#pragma unroll
            for (int m = 0; m < 4; ++m) { const int row = row0 + ai * HALF + m * 16; const bf16_t* gp = G + (size_t)row * ldg + gcol + which * 2048 + col0;
#pragma unroll
                for (int bj = 0; bj < 2; ++bj)
#pragma unroll
                    for (int n = 0; n < 2; ++n) { const int co = bj * HALF + n * 16;
                        const u32x2 ga = *(const u32x2*)(gp + co), gb = *(const u32x2*)(gp + 2048 + co);
                        f32x4 r;
                        r[0] = (1.f + __expf(-__uint_as_float(gb.x << 16))) * __builtin_amdgcn_rcpf(1.f + __expf(-__uint_as_float(ga.x << 16)));
                        r[1] = (1.f + __expf(-__uint_as_float(gb.x & 0xffff0000u))) * __builtin_amdgcn_rcpf(1.f + __expf(-__uint_as_float(ga.x & 0xffff0000u)));
                        r[2] = (1.f + __expf(-__uint_as_float(gb.y << 16))) * __builtin_amdgcn_rcpf(1.f + __expf(-__uint_as_float(ga.y << 16)));
                        r[3] = (1.f + __expf(-__uint_as_float(gb.y & 0xffff0000u))) * __builtin_amdgcn_rcpf(1.f + __expf(-__uint_as_float(ga.y & 0xffff0000u)));
                        acc[ai][bj][m][n] *= r; }
                if (m & 1) asm volatile("" ::: "memory"); }
    }
    __device__ __forceinline__ void operator()(const f32x4 (&acc)[2][2][4][2], const Unit& u, int wr, int wc, int fr, int fq) const {
        const int row0 = u.pm * BM + wr * 64 + fr, col0 = u.pn * BM + wc * 32 + 4 * fq;
#pragma unroll
        for (int ai = 0; ai < 2; ++ai)
#pragma unroll
            for (int m = 0; m < 4; ++m) { const int row = row0 + ai * HALF + m * 16; const size_t off = (size_t)row * ldc + col0; const bf16_t* gp = G + (size_t)row * ldg + gcol + 2 * 2048 + col0;
#pragma unroll
                for (int bj = 0; bj < 2; ++bj)
#pragma unroll
                    for (int n = 0; n < 2; ++n) { const int co = bj * HALF + n * 16;
                        const u32x2 gw = *(const u32x2*)(gp + co);
                        f32x4 gt; gt[0] = sigmoidf_(__uint_as_float(gw.x << 16)); gt[1] = sigmoidf_(__uint_as_float(gw.x & 0xffff0000u));
                        gt[2] = sigmoidf_(__uint_as_float(gw.y << 16)); gt[3] = sigmoidf_(__uint_as_float(gw.y & 0xffff0000u));
                        const f32x4 v = gt * acc[ai][bj][m][n];
                        u32x2 w; w.x = cvt_pk_bf16(v[0], v[1]); w.y = cvt_pk_bf16(v[2], v[3]); *(u32x2*)(ybf + off + co) = w; }
                if (m & 1) asm volatile("" ::: "memory"); }
    }
};
template <class Epi, class Sched, bool ALIGN_EPI = false, bool SP2 = false>
__device__ __forceinline__ void gemm_phase(PG8_LAS unsigned char* lds, const Gemm g, const Sched& S, const Epi& E, int tid_in) {
    const int tid = tid_in, wid = __builtin_amdgcn_readfirstlane(tid >> 6), lane = tid & 63, wr = wid >> 2, wc = wid & 3, fr = lane & 15, fq = lane >> 4;
    const int K = g.K, nt = K / BK;
    unsigned voffA[2], voffB[2];
#pragma unroll
    for (int i = 0; i < 2; ++i) { int R, C; stage_rc(tid * 16 + i * 8192, R, C); const int Rb = Epi::PERM ? ((R & ~31) + perm32(R & 31)) : R;
        voffA[i] = (unsigned)(R * K + C) * 2u; voffB[i] = (unsigned)(Rb * K + C) * 2u; }
    const size_t kstep = (size_t)(BK * 2);
    const size_t hstep = (size_t)HALF * K * 2;
    const size_t tstep = 2 * hstep;
    const unsigned ldsw = (unsigned)wid * 1024u;
    const int aoff = lds_byte(wr * 64 + fr, fq * 8), boff = lds_byte(wc * 32 + fr, fq * 8);
#define PG8_SA(b, h) (((b) * 2 + (h)) * HTB)
#define PG8_SB(b, h) ((4 + (b) * 2 + (h)) * HTB)
#define PG8_STAGE(bufoff, gbase, voff) do { _Pragma("unroll") for (int _i = 0; _i < 2; ++_i) \
        __builtin_amdgcn_global_load_lds((const unsigned*)((const char*)(gbase) + (voff)[_i]), (PG8_LAS unsigned*)(lds + (bufoff) + ldsw + _i * 8192), 16, 0, 0); } while (0)
#define PG8_LDA(dst, b, h) do { _Pragma("unroll") for (int m = 0; m < 4; ++m) _Pragma("unroll") for (int k = 0; k < 2; ++k) dst[m][k] = *(const PG8_LAS bf16x8*)(lds + PG8_SA(b, h) + aoff + m * 2048 + k * 1024); } while (0)
#define PG8_LDB(dst, b, h) do { _Pragma("unroll") for (int n = 0; n < 2; ++n) _Pragma("unroll") for (int k = 0; k < 2; ++k) dst[n][k] = *(const PG8_LAS bf16x8*)(lds + PG8_SB(b, h) + boff + n * 2048 + k * 1024); } while (0)
#define PG8_MMA(ai, bj, At, Bt) do { __builtin_amdgcn_s_setprio(1); _Pragma("unroll") for (int m = 0; m < 4; ++m) _Pragma("unroll") for (int n = 0; n < 2; ++n) _Pragma("unroll") for (int k = 0; k < 2; ++k) \
        acc[ai][bj][m][n] = __builtin_amdgcn_mfma_f32_16x16x32_bf16(Bt[n][k], At[m][k], acc[ai][bj][m][n], 0, 0, 0); __builtin_amdgcn_s_setprio(0); } while (0)
#define PG8_WAIT_V(n) asm volatile("s_waitcnt vmcnt(" #n ")" ::: "memory")
#define PG8_WAIT_L(n) asm volatile("s_waitcnt lgkmcnt(" #n ")" ::: "memory")
#define PG8_BAR __builtin_amdgcn_s_barrier()
#define PG8_SCHED __builtin_amdgcn_sched_barrier(0)
    Unit cur, nxt; int ui = 0;
    if (!S.next(0, cur)) return;
    f32x4 acc[2][2][4][2];
#pragma unroll
    for (int a = 0; a < 2; ++a)
#pragma unroll
        for (int b = 0; b < 2; ++b)
#pragma unroll
            for (int m = 0; m < 4; ++m)
#pragma unroll
                for (int n = 0; n < 2; ++n) acc[a][b][m][n] = (f32x4){0.f, 0.f, 0.f, 0.f};
    bf16x8 At[4][2], B0[2][2], B1[2][2];
    const char* cA = (const char*)g.A + (size_t)cur.pm * tstep; const char* cB = (const char*)g.Bt + (size_t)cur.pn * tstep;
    S.a_ready(cur);
    if constexpr (SP2) {
        PG8_STAGE(PG8_SB(0, 0), cB, voffB); PG8_STAGE(PG8_SB(0, 1), cB + hstep, voffB); PG8_STAGE(PG8_SA(0, 0), cA, voffA); PG8_STAGE(PG8_SA(0, 1), cA + hstep, voffA);
        if (wr == 1) PG8_BAR;
        PG8_WAIT_V(2); PG8_BAR;
        PG8_STAGE(PG8_SB(1, 0), cB + kstep, voffB); PG8_STAGE(PG8_SA(1, 0), cA + kstep, voffA); PG8_STAGE(PG8_SB(1, 1), cB + hstep + kstep, voffB);
        PG8_WAIT_V(6); PG8_BAR;
    } else {
        PG8_STAGE(PG8_SB(0, 0), cB, voffB); PG8_STAGE(PG8_SA(0, 0), cA, voffA); PG8_STAGE(PG8_SB(0, 1), cB + hstep, voffB); PG8_STAGE(PG8_SA(0, 1), cA + hstep, voffA);
        if (wr == 1) PG8_BAR;
        PG8_WAIT_V(4); PG8_BAR;
        PG8_STAGE(PG8_SB(1, 0), cB + kstep, voffB); PG8_STAGE(PG8_SA(1, 0), cA + kstep, voffA); PG8_STAGE(PG8_SB(1, 1), cB + hstep + kstep, voffB);
        PG8_WAIT_V(6); PG8_BAR;
    }
    for (;;) {
        const bool has_next = S.next(ui + 1, nxt);
        const char* nA = has_next ? (const char*)g.A + (size_t)nxt.pm * tstep : cA; const char* nB = has_next ? (const char*)g.Bt + (size_t)nxt.pn * tstep : cB;
        for (int t = 0; t < nt; t += 2) {
            if constexpr (Epi::HOOK) { if (t == 8 || t == 24) E.hook(acc, cur, wr, wc, fr, fq, t == 8 ? 0 : 1); }
            const bool last = (t == nt - 2);
            const char* a1 = cA + (size_t)(t + 1) * kstep;
            const char* a2 = last ? nA : cA + (size_t)(t + 2) * kstep; const char* b2 = last ? nB : cB + (size_t)(t + 2) * kstep;
            const char* a3 = a2 + kstep; const char* b3 = b2 + kstep;
            if (last && has_next) S.a_ready(nxt);
            if constexpr (SP2) {
            PG8_LDB(B0, 0, 0); PG8_LDB(B1, 0, 1); PG8_SCHED; PG8_LDA(At, 0, 0); PG8_STAGE(PG8_SA(1, 1), a1 + hstep, voffA);
            PG8_WAIT_V(8); PG8_WAIT_L(0); PG8_BAR; PG8_MMA(0, 0, At, B0); PG8_MMA(0, 1, At, B1); PG8_BAR; PG8_SCHED;
            PG8_LDA(At, 0, 1); PG8_STAGE(PG8_SB(0, 0), b2, voffB); PG8_STAGE(PG8_SB(0, 1), b2 + hstep, voffB); PG8_STAGE(PG8_SA(0, 0), a2, voffA);
            PG8_WAIT_V(8); PG8_WAIT_L(0); PG8_BAR; PG8_MMA(1, 0, At, B0); PG8_MMA(1, 1, At, B1); PG8_BAR; PG8_SCHED;
            PG8_LDB(B0, 1, 0); PG8_LDB(B1, 1, 1); PG8_SCHED; PG8_LDA(At, 1, 0); PG8_STAGE(PG8_SA(0, 1), a2 + hstep, voffA);
            PG8_WAIT_V(8); PG8_WAIT_L(0); PG8_BAR; PG8_MMA(0, 0, At, B0); PG8_MMA(0, 1, At, B1); PG8_BAR; PG8_SCHED;
            PG8_LDA(At, 1, 1); PG8_STAGE(PG8_SB(1, 0), b3, voffB); PG8_STAGE(PG8_SB(1, 1), b3 + hstep, voffB); PG8_STAGE(PG8_SA(1, 0), a3, voffA);
            PG8_WAIT_V(8); PG8_WAIT_L(0); PG8_BAR; PG8_MMA(1, 0, At, B0); PG8_MMA(1, 1, At, B1); PG8_BAR; PG8_SCHED;
            } else {
            PG8_LDB(B0, 0, 0); PG8_SCHED; PG8_LDA(At, 0, 0); PG8_STAGE(PG8_SA(1, 1), a1 + hstep, voffA);
            PG8_WAIT_L(8); PG8_BAR; PG8_WAIT_L(0); PG8_MMA(0, 0, At, B0); PG8_BAR; PG8_SCHED;
            PG8_LDB(B1, 0, 1); PG8_STAGE(PG8_SB(0, 0), b2, voffB);
            PG8_BAR; PG8_WAIT_L(0); PG8_MMA(0, 1, At, B1); PG8_BAR;
            PG8_LDA(At, 0, 1); PG8_STAGE(PG8_SA(0, 0), a2, voffA);
            PG8_BAR; PG8_WAIT_L(0); PG8_MMA(1, 0, At, B0); PG8_BAR; PG8_SCHED;
            PG8_STAGE(PG8_SB(0, 1), b2 + hstep, voffB);
            PG8_WAIT_V(6); PG8_BAR; PG8_MMA(1, 1, At, B1); PG8_BAR;
            PG8_LDB(B0, 1, 0); PG8_SCHED; PG8_LDA(At, 1, 0); PG8_STAGE(PG8_SA(0, 1), a2 + hstep, voffA);
            PG8_WAIT_L(8); PG8_BAR; PG8_WAIT_L(0); PG8_MMA(0, 0, At, B0); PG8_BAR; PG8_SCHED;
            PG8_LDB(B1, 1, 1); PG8_STAGE(PG8_SB(1, 0), b3, voffB);
            PG8_BAR; PG8_WAIT_L(0); PG8_MMA(0, 1, At, B1); PG8_BAR;
            PG8_LDA(At, 1, 1); PG8_STAGE(PG8_SA(1, 0), a3, voffA);
            PG8_BAR; PG8_WAIT_L(0); PG8_MMA(1, 0, At, B0); PG8_BAR; PG8_SCHED;
            PG8_STAGE(PG8_SB(1, 1), b3 + hstep, voffB);
            PG8_WAIT_V(6); PG8_BAR; PG8_MMA(1, 1, At, B1); PG8_BAR;
            }
        }
        if constexpr (ALIGN_EPI) { if (wr == 0) PG8_BAR; }
        if constexpr (!Epi::AFTER_DRAIN) { E(acc, cur, wr, wc, fr, fq); S.done(cur); }
        if (!has_next) break;
#pragma unroll
        for (int a = 0; a < 2; ++a)
#pragma unroll
            for (int b = 0; b < 2; ++b)
#pragma unroll
                for (int m = 0; m < 4; ++m)
#pragma unroll
                    for (int n = 0; n < 2; ++n) acc[a][b][m][n] = (f32x4){0.f, 0.f, 0.f, 0.f};
        cur = nxt; cA = nA; cB = nB; ++ui;
        if constexpr (ALIGN_EPI) { if (wr == 1) PG8_BAR; }
    }
    PG8_WAIT_V(0);
    if constexpr (!ALIGN_EPI) { if (wr == 0) PG8_BAR; }
    PG8_BAR;
    if constexpr (Epi::AFTER_DRAIN) { E.fused(acc, cur, wr, wc, fr, fq, lds, wid, lane); S.done(cur); }
#undef PG8_SA
#undef PG8_SB
#undef PG8_STAGE
#undef PG8_LDA
#undef PG8_LDB
#undef PG8_MMA
#undef PG8_WAIT_V
#undef PG8_WAIT_L
#undef PG8_BAR
#undef PG8_SCHED
}
}
namespace pg8 { typedef PG8_LAS unsigned char* PG8_LAS_T; }
constexpr int LDP_ATT = 12032;
namespace att {
constexpr int D = 128, LDP = LDP_ATT; constexpr float SCALE = 0.08838834764831845f; constexpr float THR = 8.f;
constexpr int NW = 8, QBLK = 32, KVBLK = 64, QB = NW * QBLK; constexpr int SHM_V = KVBLK * D * 2, SHM_K = KVBLK * D * 2; constexpr int LDS_ATT = 2 * SHM_V + 2 * SHM_K + NW * 64 * 4;
using bf16 = __hip_bfloat16;
typedef short bf16x8 __attribute__((ext_vector_type(8)));
typedef short s16x4 __attribute__((ext_vector_type(4)));
typedef float f32x16 __attribute__((ext_vector_type(16)));
typedef float f32x4 __attribute__((ext_vector_type(4)));
typedef unsigned u32x4 __attribute__((ext_vector_type(4)));
template <class A, class Bt> struct same_t { static constexpr bool v = false; };
template <class A> struct same_t<A, A> { static constexpr bool v = true; };

#define KSWZ(row, colB) ((row) * 256 + ((colB) ^ (((row) & 7) << 4)))
#define SBAR() __builtin_amdgcn_sched_barrier(0)
__device__ __forceinline__ int v_st(int k, int c) { const int kk = (k & ~0xC) | ((k & 4) << 1) | ((k & 8) >> 1); return ((kk >> 3) * 4 + (c >> 5)) * 512 + ((kk & 7) * 32 + (c & 31)) * 2; }
__device__ __forceinline__ int v_rd_base(int lane) { return ((lane & 3) << 3) | (((lane >> 2) & 3) << 6) | (((lane >> 4) & 1) << 5) | (((lane >> 5) & 1) << 8); }
constexpr int v_rd_off(int d0, int ks, int half) { return d0 * 512 + ks * 4096 + half * 2048; }
__device__ __forceinline__ int crow(int r, int hi) { return (r & 3) + 8 * (r >> 2) + 4 * hi; }
__device__ __forceinline__ unsigned cvtpk(float lo, float hi) {
    unsigned r; asm volatile("v_cvt_pk_bf16_f32 %0, %1, %2" : "=v"(r) : "v"(lo), "v"(hi)); return r;
}
__device__ __forceinline__ bf16x8 pack8(f32x4 a, f32x4 b) {
    u32x4 w = {cvtpk(a[0], a[1]), cvtpk(a[2], a[3]), cvtpk(b[0], b[1]), cvtpk(b[2], b[3])};
    return *reinterpret_cast<bf16x8*>(&w);
}
template <class T> __device__ __forceinline__ bf16x8 load8(const T* p) {
    if constexpr (same_t<T, float>::v) { return pack8(*(const f32x4*)p, *(const f32x4*)(p + 4)); }
    else { return *reinterpret_cast<const bf16x8*>(p); }
}
__device__ __forceinline__ void mask_tile(f32x16& p0, f32x16& p1, int dq, unsigned W) {
    const float NEG = -__builtin_inff();
#pragma unroll
    for (int r = 0; r < 16; ++r) {
        const int c = (r & 3) + 8 * (r >> 2);
        if ((unsigned)(dq - c) >= W) p0[r] = NEG;
        if ((unsigned)(dq - c - 32) >= W) p1[r] = NEG;
    }
}
__device__ __forceinline__ void partialSM(f32x16& p0, f32x16& p1, float& m_reg, float& mn, float& alpha) {
    float pmax = p0[0]; for (int r = 1; r < 16; ++r) pmax = fmaxf(pmax, p0[r]); for (int r = 0; r < 16; ++r) pmax = fmaxf(pmax, p1[r]);
    { auto rr = __builtin_amdgcn_permlane32_swap(__float_as_uint(pmax), __float_as_uint(pmax), false, false);
      pmax = fmaxf(__uint_as_float(rr[0]), __uint_as_float(rr[1])); }
    constexpr float C2 = 1.4426950408889634f * SCALE;
    if (__builtin_expect(__all((pmax - m_reg) * SCALE <= THR), 1)) { mn = m_reg; alpha = 1.f; }
    else { mn = fmaxf(m_reg, pmax); alpha = __builtin_amdgcn_exp2f((m_reg - mn) * C2); m_reg = mn; }
    const float mnL = -mn * C2;
    for (int r = 0; r < 16; ++r) p0[r] = fmaf(p0[r], C2, mnL); for (int r = 0; r < 16; ++r) p1[r] = fmaf(p1[r], C2, mnL);
    for (int r = 0; r < 16; ++r) p0[r] = __builtin_amdgcn_exp2f(p0[r]);
}
__device__ __forceinline__ void finishSM(f32x16& p0, f32x16& p1, float alpha, float& l_reg, bf16x8& pa0, bf16x8& pa1, bf16x8& pa2, bf16x8& pa3) {
    for (int r = 0; r < 16; ++r) p1[r] = __builtin_amdgcn_exp2f(p1[r]);
    float ps = 0; for (int r = 0; r < 16; ++r) ps += p0[r]; for (int r = 0; r < 16; ++r) ps += p1[r];
    { auto rr = __builtin_amdgcn_permlane32_swap(__float_as_uint(ps), __float_as_uint(ps), false, false);
      ps = __uint_as_float(rr[0]) + __uint_as_float(rr[1]); }
    l_reg = l_reg * alpha + ps;
#define PK4(P, B_, OUT) do { unsigned a0 = cvtpk(P[B_+0], P[B_+1]), a1 = cvtpk(P[B_+2], P[B_+3]);                          \
        unsigned b0 = cvtpk(P[B_+4], P[B_+5]), b1 = cvtpk(P[B_+6], P[B_+7]);                                             \
        auto r0 = __builtin_amdgcn_permlane32_swap(a0, b0, false, false); auto r1 = __builtin_amdgcn_permlane32_swap(a1, b1, false, false); \
        u32x4 w = {r0[0], r1[0], r0[1], r1[1]}; OUT = *reinterpret_cast<bf16x8*>(&w); } while (0)
    PK4(p0, 0, pa0); PK4(p0, 8, pa1); PK4(p1, 0, pa2); PK4(p1, 8, pa3);
#undef PK4
}
enum { M_DA = 0, M_FOX = 1, M_SEL = 2, M_WIN = 3 };
template <int KB, int MODE>
__device__ __forceinline__ void qkt(f32x16& p0, f32x16& p1, const char* K_lds, int r32, int hi, const bf16x8* qr) {
    p0 = f32x16{}; p1 = f32x16{};
    const char* kb[4];
#pragma unroll
    for (int dd = 0; dd < 4; ++dd) kb[dd] = K_lds + KB * SHM_K + KSWZ(r32, (dd * 16 + hi * 8) * 2);
    constexpr int ND = (MODE == M_DA) ? 4 : 8;
#pragma unroll
    for (int d0 = 0; d0 < ND; ++d0) { const char* a = kb[d0 & 3] + (d0 >> 2) * 128;
        bf16x8 b0 = *reinterpret_cast<const bf16x8*>(a);
        bf16x8 b1 = *reinterpret_cast<const bf16x8*>(a + 32 * 256);
        p0 = __builtin_amdgcn_mfma_f32_32x32x16_bf16(b0, qr[d0], p0, 0, 0, 0);
        p1 = __builtin_amdgcn_mfma_f32_32x32x16_bf16(b1, qr[d0], p1, 0, 0, 0); }
}
template <int VB, bool SK>
__device__ __forceinline__ void pv_tile(f32x16* o, int vb0, bf16x8 pa0, bf16x8 pa1, bf16x8 pa2, bf16x8 pa3, bool act) {
    if (SK && !act) return;
#define TRRD(dst, off) asm volatile("ds_read_b64_tr_b16 %0, %1 offset:%2" : "=&v"(dst) : "v"(vb0), "i"(off) : "memory")
#define PV_D0(d0) do { s16x4 l0, l1, l2, l3, h0, h1, h2, h3; constexpr int b_ = VB * SHM_V + v_rd_off(d0, 0, 0);     \
        TRRD(l0, b_); TRRD(h0, b_ + 2048); TRRD(l1, b_ + 4096); TRRD(h1, b_ + 6144); TRRD(l2, b_ + 8192); TRRD(h2, b_ + 10240); TRRD(l3, b_ + 12288); TRRD(h3, b_ + 14336); \
        asm volatile("s_waitcnt lgkmcnt(0)" ::: "memory"); SBAR();                 \
        o[d0] = __builtin_amdgcn_mfma_f32_32x32x16_bf16(pa0, (bf16x8){l0[0], l0[1], l0[2], l0[3], h0[0], h0[1], h0[2], h0[3]}, o[d0], 0, 0, 0);   \
        o[d0] = __builtin_amdgcn_mfma_f32_32x32x16_bf16(pa1, (bf16x8){l1[0], l1[1], l1[2], l1[3], h1[0], h1[1], h1[2], h1[3]}, o[d0], 0, 0, 0);   \
        o[d0] = __builtin_amdgcn_mfma_f32_32x32x16_bf16(pa2, (bf16x8){l2[0], l2[1], l2[2], l2[3], h2[0], h2[1], h2[2], h2[3]}, o[d0], 0, 0, 0);   \
        o[d0] = __builtin_amdgcn_mfma_f32_32x32x16_bf16(pa3, (bf16x8){l3[0], l3[1], l3[2], l3[3], h3[0], h3[1], h3[2], h3[3]}, o[d0], 0, 0, 0); } while (0)
    PV_D0(0); PV_D0(1); PV_D0(2); PV_D0(3);
#undef PV_D0
#undef TRRD
}

struct BlockRef { const bf16* Q; const bf16* K; const bf16* V; bf16* O; int P0; int ldo; const float* cks; const unsigned* sel; };
struct Seam { bf16x8 qr[8]; bf16x8 st_v0, st_v1, st_k0, st_k1; };
__device__ __forceinline__ int swa_jlo(int P0, int W) { const int lowk = P0 - W + 1; return lowk > 0 ? lowk / KVBLK : 0; }
#define ROW(p, k0, rr) ((p) + (size_t)((k0) + (rr)) * LDP + sc)
#define VMW() asm volatile("s_waitcnt vmcnt(0)" ::: "memory")
#define VMWN(n) asm volatile("s_waitcnt vmcnt(%0)" :: "i"(n) : "memory")
#define SLOAD_H(Kp, Vp, k0) do { S.st_v0 = load8<bf16>(ROW(Vp, k0, sr)); S.st_v1 = load8<bf16>(ROW(Vp, k0, 32 + sr));              \
                         S.st_k0 = load8<bf16>(ROW(Kp, k0, sr)); S.st_k1 = load8<bf16>(ROW(Kp, k0, 32 + sr)); } while (0)
#define SWRITE_HK(bf) do { *(bf16x8*)(K_lds + (bf) * SHM_K + kws) = S.st_k0; *(bf16x8*)(K_lds + (bf) * SHM_K + kws + 32 * 256) = S.st_k1; } while (0)
#define SWRITE_HV(bf) do { *(bf16x8*)(V_lds + (bf) * SHM_V + vst0) = S.st_v0; *(bf16x8*)(V_lds + (bf) * SHM_V + vst1) = S.st_v1; } while (0)
#define SWRITE_H(bf) do { SWRITE_HV(bf); SWRITE_HK(bf); } while (0)
template <int MODE>
__device__ __forceinline__ void att_prime(const BlockRef& cur, int W, char* lds, Seam& S, int tid_in) {
    constexpr int ND = (MODE == M_DA) ? 4 : 8;
    const int tid = tid_in, wid = __builtin_amdgcn_readfirstlane(tid >> 6), lane = tid & 63, r32 = lane & 31, hi = lane >> 5;
    const int sr = tid >> 4, sc = (tid & 15) * 8, kws = KSWZ(sr, sc * 2); char* K_lds = lds + 2 * SHM_V;
    const int kb0 = swa_jlo(cur.P0, W) * KVBLK;
#pragma unroll
    for (int d0 = 0; d0 < ND; ++d0) S.qr[d0] = load8<bf16>(cur.Q + (size_t)(wid * QBLK + r32) * LDP + d0 * 16 + hi * 8);
    SLOAD_H(cur.K, cur.V, kb0); VMW(); SWRITE_HK(0);
    __syncthreads();
}
template <int MODE>
__device__ __forceinline__ void att_block(const BlockRef& cur, const BlockRef& nxt, int skv, int W, char* lds, Seam& S, int tid_in) {
    constexpr int ND = (MODE == M_DA) ? 4 : 8;
    const int tid = tid_in, wid = __builtin_amdgcn_readfirstlane(tid >> 6), lane = tid & 63, r32 = lane & 31, hi = lane >> 5;
    const int j_lo = swa_jlo(cur.P0, W);
    int j_hi = (cur.P0 + QB - 1) / KVBLK + 1; if (j_hi > skv / KVBLK) j_hi = skv / KVBLK;
    const int NT = j_hi - j_lo;
    const int kbn = swa_jlo(nxt.P0, W) * KVBLK;
    const int qlo = cur.P0 + wid * QBLK, qm = qlo + r32 - 4 * hi;
    char* V_lds = lds; char* K_lds = lds + 2 * SHM_V;
    float* ws = (float*)(lds + 2 * SHM_V + 2 * SHM_K) + wid * 64; float* li_l = ws, * al_l = ws + 32;
    float* ck_l = (float*)(lds + LDS_ATT);
    float m_reg = -1e30f, l_reg = 0; f32x16 o[4] = {};
    const int sr = tid >> 4, sc = (tid & 15) * 8, vst0 = v_st(sr, sc), vst1 = v_st(32 + sr, sc), kws = KSWZ(sr, sc * 2);
    const int vb0 = (int)(uintptr_t)V_lds + v_rd_base(lane);
    const bf16* Kh = cur.K; const bf16* Vh = cur.V;
    unsigned selw = 0xffffffffu;
    if constexpr (MODE == M_SEL) selw = cur.sel[qlo + r32];
    if constexpr (MODE == M_FOX) {
        for (int i = tid; i < cur.P0 + QB; i += 64 * NW) ck_l[i] = cur.cks[i];
        __syncthreads(); }
#define RESC(a) do { if (__any((a) < 1.f)) { if (hi == 0) al_l[r32] = (a); asm volatile("s_waitcnt lgkmcnt(0)" ::: "memory");              \
                     for (int d_ = 0; d_ < 4; ++d_) for (int r = 0; r < 16; ++r) o[d_][r] *= al_l[crow(r, hi)]; } } while (0)
#define KBASE(t) ((j_lo + (t)) * KVBLK)
#define MASKT(P0_, P1_, t) do { const int kb_ = KBASE(t); \
        if constexpr (MODE == M_FOX) { const float* c_ = ck_l + kb_ + 4 * hi; const float cq_ = ck_l[qm + 4 * hi]; \
            _Pragma("unroll") for (int i_ = 0; i_ < 4; ++i_) { const f32x4 a_ = *(const f32x4*)(c_ + 8 * i_), b_ = *(const f32x4*)(c_ + 32 + 8 * i_); \
                _Pragma("unroll") for (int j_ = 0; j_ < 4; ++j_) { P0_[4 * i_ + j_] += cq_ - a_[j_]; P1_[4 * i_ + j_] += cq_ - b_[j_]; } } } \
        if (kb_ + KVBLK - 1 > qlo || kb_ <= qlo + QBLK - 1 - W) mask_tile(P0_, P1_, qm - kb_, (unsigned)W); \
        if constexpr (MODE == M_SEL) { if (!((selw >> (j_lo + (t))) & 1u)) { const float NEG_ = -__builtin_inff(); \
            _Pragma("unroll") for (int r = 0; r < 16; ++r) { P0_[r] = NEG_; P1_[r] = NEG_; } } } } while (0)
#define SEAM_K0() do { VMWN(ND); SWRITE_HK(0); SBAR(); } while (0)
    f32x16 pA0, pA1, pB0, pB1; float mnA, mnB, alA, alB; bf16x8 pa0, pa1, pa2, pa3;
    SWRITE_HV(0); SBAR();
    if (NT > 1) { SLOAD_H(Kh, Vh, KBASE(1)); }
    SBAR(); qkt<0, MODE>(pA0, pA1, K_lds, r32, hi, S.qr);
    MASKT(pA0, pA1, 0); partialSM(pA0, pA1, m_reg, mnA, alA);
    if (NT > 1) { VMW(); SWRITE_H(1); }
    __syncthreads();
#define HALF_STEP(PX0, PX1, mnX, alX, PY0, PY1, alY, t, KB, VB, SB) do {                                                      \
        SBAR(); qkt<KB, MODE>(PX0, PX1, K_lds, r32, hi, S.qr);                                             \
        finishSM(PY0, PY1, alY, l_reg, pa0, pa1, pa2, pa3); SBAR();                                                           \
        if ((t) + 1 < NT) { SLOAD_H(Kh, Vh, KBASE((t) + 1)); SBAR(); }                                               \
        pv_tile<VB, false>(o, vb0, pa0, pa1, pa2, pa3, true); MASKT(PX0, PX1, (t)); partialSM(PX0, PX1, m_reg, mnX, alX);                                        \
        __syncthreads();                                                                                                      \
        if ((t) + 1 < NT) { VMW(); SWRITE_H(SB); }                                                                          \
        RESC(alX); __syncthreads(); } while (0)
    for (int t = 1; t + 1 < NT; t += 2) {
        HALF_STEP(pB0, pB1, mnB, alB, pA0, pA1, alA, t, 1, 0, 0);
        HALF_STEP(pA0, pA1, mnA, alA, pB0, pB1, alB, t + 1, 0, 1, 1);
    }
    const bool even = (NT & 1) == 0;
    if (even) { SBAR(); qkt<1, MODE>(pB0, pB1, K_lds, r32, hi, S.qr); SBAR(); }
    SLOAD_H(nxt.K, nxt.V, kbn); SBAR();
#pragma unroll
    for (int d0 = 0; d0 < ND; ++d0) S.qr[d0] = load8<bf16>(nxt.Q + (size_t)(wid * QBLK + r32) * LDP + d0 * 16 + hi * 8);
    SBAR();
    finishSM(pA0, pA1, alA, l_reg, pa0, pa1, pa2, pa3); SBAR();
    pv_tile<0, false>(o, vb0, pa0, pa1, pa2, pa3, true);
    if (even) { MASKT(pB0, pB1, NT - 1); partialSM(pB0, pB1, m_reg, mnB, alB); __syncthreads(); RESC(alB);
        finishSM(pB0, pB1, alB, l_reg, pa0, pa1, pa2, pa3); SBAR(); pv_tile<1, false>(o, vb0, pa0, pa1, pa2, pa3, true); }
    SBAR(); SEAM_K0();
    if (hi == 0) li_l[r32] = l_reg; asm volatile("s_waitcnt lgkmcnt(0)" ::: "memory");
    float rli[16];
#pragma unroll
    for (int r = 0; r < 16; ++r) rli[r] = __builtin_amdgcn_rcpf(li_l[crow(r, hi)]);
    const int ldo = cur.ldo;
    bf16* Ow = cur.O + (size_t)(wid * QBLK) * ldo;
#pragma unroll
    for (int r = 0; r < 16; ++r) { const int orow = crow(r, hi);
#pragma unroll
        for (int d0 = 0; d0 < 4; ++d0) { const float v = o[d0][r] * rli[r];
            const float vn = __int_as_float(__builtin_amdgcn_mov_dpp(__float_as_int(v), 0xB1, 0xF, 0xF, true));
            if ((r32 & 1) == 0) *(unsigned*)(Ow + (size_t)orow * ldo + d0 * 32 + r32) = cvtpk(v, vn); } }
    __syncthreads();
#undef RESC
#undef KBASE
#undef MASKT
#undef SEAM_K0
#undef HALF_STEP
}
#undef ROW
#undef VMW
#undef VMWN
#undef SLOAD_H
#undef SWRITE_HK
#undef SWRITE_HV
#undef SWRITE_H
#undef KSWZ
#undef SBAR
}
constexpr int NBATCH = 4, SEQ = 2048, T = NBATCH * SEQ, DM = 2048, FF = 5632, DEPTH = 2;
constexpr int LDP = 12032;
constexpr int PC_AQ = 0, PC_AK = 512, PC_AV = 1024, PC_BQ = 1536, PC_BKV = 2560, PC_CQ = 4096, PC_CK = 4608, PC_CV = 5120, PC_GM = 5632, PC_BG = 11776, PC_CF = 11800;
constexpr float EPS = 1e-6f;
constexpr int NWAVES = 8, NTHR = 512;
typedef unsigned short bf16r;
typedef float f32x2 __attribute__((ext_vector_type(2)));
typedef float f32x4 __attribute__((ext_vector_type(4)));
typedef float f32x16 __attribute__((ext_vector_type(16)));
typedef short bf16x8 __attribute__((ext_vector_type(8)));
typedef unsigned u32x4 __attribute__((ext_vector_type(4)));
typedef unsigned u32x2 __attribute__((ext_vector_type(2)));
constexpr size_t MiB = 1u << 20;
constexpr size_t WS_CTL = 0;
constexpr size_t WS_WGU1 = 1 * MiB, WS_WD1 = WS_WGU1 + 44 * MiB, WS_WGU2 = WS_WD1 + 22 * MiB, WS_WD2 = WS_WGU2 + 44 * MiB, WS_WIN = WS_WD2 + 22 * MiB;
constexpr size_t WS_WA = WS_WIN + 47 * MiB, WS_WB = WS_WA + 2 * MiB, WS_WC = WS_WB + 4 * MiB, WS_WO = WS_WC + 2 * MiB, WS_W1T = WS_WO + 8 * MiB;
constexpr size_t WS_H = WS_W1T + 4 * MiB;
constexpr size_t WS_P = WS_H + 32 * MiB;
constexpr size_t WS_YACC = WS_P + 188 * MiB;
constexpr size_t WS_YBF = WS_YACC + 64 * MiB;
constexpr size_t WS_OA = WS_YBF + 32 * MiB, WS_OB = WS_OA + 8 * MiB, WS_OC = WS_OB + 16 * MiB;
constexpr size_t WS_RDA = WS_OC + 8 * MiB, WS_RSEL = WS_RDA + 16 * MiB, WS_RWIN = WS_RSEL + 16 * MiB, WS_OCMP = WS_RWIN + 16 * MiB;
constexpr size_t WS_CPART = WS_OCMP + 16 * MiB;
constexpr size_t WS_SMALL = WS_CPART + 8 * MiB;
constexpr size_t WS_LOGF = WS_SMALL, WS_CUMS = WS_LOGF + 128 * 1024, WS_SELM = WS_CUMS + 128 * 1024, WS_KC = WS_SELM + 64 * 1024, WS_VC = WS_KC + 128 * 1024;
constexpr size_t WS_RS = WS_SMALL + 1 * MiB;
constexpr size_t WS_END = WS_RS + 7 * MiB;
constexpr int LDS_BYTES = 147456;
constexpr int LDS_SLOT = 140000;

__device__ __forceinline__ float bf2f(unsigned short h) { return __uint_as_float(((unsigned)h) << 16); }
__device__ __forceinline__ unsigned pk2(float lo, float hi) { return pg8::cvt_pk_bf16(lo, hi); }
__device__ __forceinline__ float shx(float v, int msk, int lane) { return __int_as_float(__builtin_amdgcn_ds_bpermute((lane ^ msk) << 2, __float_as_int(v))); }
__device__ __forceinline__ float wsum(float v, int lane) {
#pragma unroll
    for (int o = 1; o < 64; o <<= 1) v += shx(v, o, lane);
    return v; }
__device__ __forceinline__ float hsum32(float v, int lane) {
#pragma unroll
    for (int o = 1; o < 32; o <<= 1) v += shx(v, o, lane);
    return v; }
#define LDSW() asm volatile("s_waitcnt lgkmcnt(0)" ::: "memory")

struct Params { const float* in[28]; float* out; unsigned char* ws; int ph_lo, ph_hi; };

__device__ __forceinline__ int win_src(int n) {
    if (n < 4096) return n; if (n < 5632) return n + 24; if (n < 11776) return n + 28; if (n < 11800) return 4096 + (n - 11776); if (n < 11804) return 5656 + (n - 11800); return -1; }
__device__ __forceinline__ void cvt_item(const float* W, int ldw, int K, bf16r* WT, int kind, int item, int nblk, float* scr, int lane, int ldk = 0, int koff = 0) {
    if (ldk == 0) ldk = K;
    const int kb = item / nblk, nb = item - kb * nblk, k0 = 64 * kb, n0 = 32 * nb;
    const int nl = n0 + (lane & 31);
    int sc = nl; if (kind == 3) sc = win_src(nl);
    const float* wp = W + (size_t)(k0 + (lane >> 5)) * ldw + (sc < 0 ? 0 : sc);
#pragma unroll 8
    for (int i = 0; i < 32; ++i) { const float v = wp[(size_t)(2 * i) * ldw]; scr[(2 * i + (lane >> 5)) * 33 + (lane & 31)] = sc < 0 ? 0.f : v; }
    LDSW();
    const int c = lane & 7;
#pragma unroll
    for (int j = 0; j < 4; ++j) { const int n = (lane >> 3) + 8 * j; const float* s = scr + (8 * c) * 33 + n; const int nlog = n0 + n;
        int drow = nlog; if (kind == 1 || kind == 2) drow = (nlog >> 7) * 256 + (nlog & 127) + (kind == 2 ? 128 : 0);
        u32x4 o; o.x = pk2(s[0 * 33], s[1 * 33]); o.y = pk2(s[2 * 33], s[3 * 33]); o.z = pk2(s[4 * 33], s[5 * 33]); o.w = pk2(s[6 * 33], s[7 * 33]);
        *(u32x4*)(WT + (size_t)drow * ldk + koff + k0 + 8 * c) = o; }
    LDSW();
}
__device__ __forceinline__ void phase_convert(const Params& p, int layer, char* lds, int gw, int NGW, int wave, int lane) {
    float* scr = (float*)(lds + wave * 8704);
    unsigned char* ws = p.ws;
    constexpr int I_G = 32 * 176, I_D = 88 * 64, I_WIN = 32 * 376, I_A = 8 * 64, I_B = 16 * 64, I_O = 32 * 64, I_W1 = 128 * 4;
    constexpr int NIT = 4 * I_G + 2 * I_D + I_WIN + 2 * I_A + I_B + I_O + 2 * I_W1;
    const size_t lF = (size_t)layer * DM * FF;
    for (int it = gw; it < NIT; it += NGW) {
        int r = it;
        if (r < I_G) { cvt_item(p.in[3] + lF, FF, DM, (bf16r*)(ws + WS_WGU1), 1, r, 176, scr, lane); continue; } r -= I_G;
        if (r < I_G) { cvt_item(p.in[4] + lF, FF, DM, (bf16r*)(ws + WS_WGU1), 2, r, 176, scr, lane); continue; } r -= I_G;
        if (r < I_D) { cvt_item(p.in[5] + lF, DM, FF, (bf16r*)(ws + WS_WD1), 0, r, 64, scr, lane); continue; } r -= I_D;
        if (r < I_G) { cvt_item(p.in[25] + lF, FF, DM, (bf16r*)(ws + WS_WGU2), 1, r, 176, scr, lane); continue; } r -= I_G;
        if (r < I_G) { cvt_item(p.in[26] + lF, FF, DM, (bf16r*)(ws + WS_WGU2), 2, r, 176, scr, lane); continue; } r -= I_G;
        if (r < I_D) { cvt_item(p.in[27] + lF, DM, FF, (bf16r*)(ws + WS_WD2), 0, r, 64, scr, lane); continue; } r -= I_D;
        if (r < I_WIN) { cvt_item(p.in[7] + (size_t)layer * DM * 11804, 11804, DM, (bf16r*)(ws + WS_WIN), 3, r, 376, scr, lane); continue; } r -= I_WIN;
        if (r < I_A) { cvt_item(p.in[20] + (size_t)layer * 512 * DM, DM, 512, (bf16r*)(ws + WS_WA), 0, r, 64, scr, lane, 2048, 0); continue; } r -= I_A;
        if (r < I_B) { cvt_item(p.in[21] + (size_t)layer * 1024 * DM, DM, 1024, (bf16r*)(ws + WS_WA), 0, r, 64, scr, lane, 2048, 512); continue; } r -= I_B;
        if (r < I_A) { cvt_item(p.in[22] + (size_t)layer * 512 * DM, DM, 512, (bf16r*)(ws + WS_WA), 0, r, 64, scr, lane, 2048, 1536); continue; } r -= I_A;
        if (r < I_O) { cvt_item(p.in[23] + (size_t)layer * DM * DM, DM, DM, (bf16r*)(ws + WS_WO), 0, r, 64, scr, lane); continue; } r -= I_O;
        if (r < I_W1) { cvt_item(p.in[15] + (size_t)(layer * 2 + 0) * 8192 * 128, 128, 8192, (bf16r*)(ws + WS_W1T), 0, r, 4, scr, lane); continue; } r -= I_W1;
        cvt_item(p.in[15] + (size_t)(layer * 2 + 1) * 8192 * 128, 128, 8192, (bf16r*)(ws + WS_W1T) + 128 * 8192, 0, r, 4, scr, lane);
    }
}
__device__ __forceinline__ void phase_rms(const float* X, const float* gain, bf16r* H, unsigned long long* rss, int gw, int NGW, int lane) {
    f32x4 g[8];
#pragma unroll
    for (int j = 0; j < 8; ++j) g[j] = ((const f32x4*)gain)[64 * j + lane];
    for (int m = gw; m < T; m += NGW) {
        const f32x4* xr = (const f32x4*)(X + (size_t)m * DM) + lane;
        f32x4 v[8]; float s = 0.f;
#pragma unroll
        for (int j = 0; j < 8; ++j) { v[j] = xr[64 * j]; s += (v[j].x * v[j].x + v[j].y * v[j].y) + (v[j].z * v[j].z + v[j].w * v[j].w); }
        s = wsum(s, lane); if (lane == 0) rss[m] = (unsigned long long)((double)s * 65536.0 + 0.5);
        u32x2* o = (u32x2*)(H + (size_t)m * DM) + lane;
#pragma unroll
        for (int j = 0; j < 8; ++j) { u32x2 w; w.x = pk2(v[j].x * g[j].x, v[j].y * g[j].y); w.y = pk2(v[j].z * g[j].z, v[j].w * g[j].w); o[64 * j] = w; }
    }
}
template <int KIND>
__device__ __forceinline__ unsigned prep_chunk(const unsigned w, const float* gain, float scale, int lane, float c0, float s0, float c1, float s1) {
    float x0 = __uint_as_float(w << 16), x1 = __uint_as_float(w & 0xffff0000u);
    if (KIND == 0 || KIND == 2) { const float r = rsqrtf(wsum(x0 * x0 + x1 * x1, lane) * (1.f / 128.f) + EPS); x0 = x0 * r * gain[2 * lane]; x1 = x1 * r * gain[2 * lane + 1]; }
    if (KIND == 3) { const float r = rsqrtf(hsum32(x0 * x0 + x1 * x1, lane) * (1.f / 64.f) + EPS); x0 = x0 * r * gain[(2 * lane) & 63] * scale; x1 = x1 * r * gain[(2 * lane + 1) & 63] * scale; }
    if (KIND == 0 || KIND == 1) { const float y0 = shx(x0, 8, lane), y1 = shx(x1, 8, lane);
        if (lane < 8) { x0 = x0 * c0 - y0 * s0; x1 = x1 * c1 - y1 * s1; } else if (lane < 16) { x0 = x0 * c0 + y0 * s0; x1 = x1 * c1 + y1 * s1; } }
    if (KIND == 3) { const float y0 = shx(x0, 4, lane), y1 = shx(x1, 4, lane); const int l2 = lane & 31;
        if (l2 < 4) { x0 = x0 * c0 - y0 * s0; x1 = x1 * c1 - y1 * s1; } else if (l2 < 8) { x0 = x0 * c0 + y0 * s0; x1 = x1 * c1 + y1 * s1; } }
    return pk2(x0, x1);
}
__device__ __forceinline__ void rope_cs(float pos, float inv, float& c, float& s) {
    const float a = pos * inv; const double rev = (double)a * 0.15915494309189535; const float fr = (float)(rev - __builtin_rint(rev));
    c = __builtin_amdgcn_cosf(fr); s = __builtin_amdgcn_sinf(fr); }
__device__ __forceinline__ void phase_prep(const Params& p, int layer, int gw, int NGW, int lane) {
    bf16r* P = (bf16r*)(p.ws + WS_P); float* LOGF = (float*)(p.ws + WS_LOGF);
    const float* gaq = p.in[8] + layer * 64; const float* gak = p.in[9] + layer * 64; const float* gbq = p.in[12] + layer * 128; const float* gbk = p.in[13] + layer * 384;
    const float* gcq = p.in[17] + layer * 128; const float* gck = p.in[18] + layer * 128; const float* fb = p.in[19] + layer * 4;
    const int* positions = (const int*)p.in[1];
    const int fbi = 2 * (lane & 7), fai = 2 * (lane & 3);
    const float L2T = 18.931568569324174f; const float ib0 = __builtin_amdgcn_exp2f(-(float)fbi * (L2T / 16.f)), ib1 = __builtin_amdgcn_exp2f(-(float)(fbi + 1) * (L2T / 16.f));
    const float ia0 = __builtin_amdgcn_exp2f(-(float)fai * (L2T / 8.f)), ia1 = __builtin_amdgcn_exp2f(-(float)(fai + 1) * (L2T / 8.f));
    for (int tok = gw; tok < T; tok += NGW) {
        const float pos = (float)positions[tok];
        float cb0, sb0, cb1, sb1, ca0, sa0, ca1, sa1;
        rope_cs(pos, ib0, cb0, sb0); rope_cs(pos, ib1, cb1, sb1); rope_cs(pos, ia0, ca0, sa0); rope_cs(pos, ia1, ca1, sa1);
        bf16r* row = P + (size_t)tok * LDP;
        unsigned* rw = (unsigned*)row + lane;
        unsigned wq[8], wb[8], wk[6], wc[8];
#pragma unroll
        for (int i = 0; i < 8; ++i) wq[i] = rw[(PC_AQ + i * 128) / 2];
#pragma unroll
        for (int i = 0; i < 8; ++i) wb[i] = rw[(PC_BQ + i * 128) / 2];
#pragma unroll
        for (int i = 0; i < 6; ++i) wk[i] = rw[(PC_BKV + (i >> 1) * 512 + (i & 1) * 128) / 2];
#pragma unroll
        for (int i = 0; i < 8; ++i) wc[i] = rw[(PC_CQ + i * 128) / 2];
        const float cfv = (lane < 4) ? bf2f(row[PC_CF + lane]) : 0.f;
#pragma unroll
        for (int i = 0; i < 4; ++i) wq[i] = prep_chunk<3>(wq[i], gaq, 1.41421356237f, lane, ca0, sa0, ca1, sa1);
#pragma unroll
        for (int i = 4; i < 8; ++i) wq[i] = prep_chunk<3>(wq[i], gak, 1.f, lane, ca0, sa0, ca1, sa1);
#pragma unroll
        for (int i = 0; i < 8; ++i) wb[i] = prep_chunk<0>(wb[i], gbq, 1.f, lane, cb0, sb0, cb1, sb1);
#pragma unroll
        for (int i = 0; i < 2; ++i) { wk[i] = prep_chunk<1>(wk[i], gbq, 1.f, lane, cb0, sb0, cb1, sb1);
            wk[2 + i] = prep_chunk<0>(wk[2 + i], gbk + 128, 1.f, lane, cb0, sb0, cb1, sb1);
            wk[4 + i] = prep_chunk<0>(wk[4 + i], gbk + 256, 1.f, lane, cb0, sb0, cb1, sb1); }
#pragma unroll
        for (int i = 0; i < 4; ++i) { wc[i] = prep_chunk<2>(wc[i], gcq, 1.f, lane, 0, 0, 0, 0); wc[4 + i] = prep_chunk<2>(wc[4 + i], gck, 1.f, lane, 0, 0, 0, 0); }
#pragma unroll
        for (int i = 0; i < 8; ++i) rw[(PC_AQ + i * 128) / 2] = wq[i];
#pragma unroll
        for (int i = 0; i < 8; ++i) rw[(PC_BQ + i * 128) / 2] = wb[i];
#pragma unroll
        for (int i = 0; i < 6; ++i) rw[(PC_BKV + (i >> 1) * 512 + (i & 1) * 128) / 2] = wk[i];
#pragma unroll
        for (int i = 0; i < 8; ++i) rw[(PC_CQ + i * 128) / 2] = wc[i];
        if (lane < 4) { const float c = cfv + fb[lane]; const float lf = fminf(c, 0.f) - __logf(1.f + __expf(-fabsf(c)));
            const int b = tok / SEQ, s = tok - b * SEQ; LOGF[(size_t)(b * 4 + lane) * SEQ + s] = lf; }
    }
}
__device__ __forceinline__ void phase_cmp1(const Params& p, int layer, int gw, int NGW, int lane) {
    const bf16r* P = (const bf16r*)(p.ws + WS_P); const bf16r* W1T = (const bf16r*)(p.ws + WS_W1T); float* CPART = (float*)(p.ws + WS_CPART);
    const int hi = lane >> 5, l32 = lane & 31;
    for (int it = gw; it < 2048; it += NGW) {
        const int kind = it >> 10, rem = it & 1023, kc = rem & 31, nt = (rem >> 5) & 3, rt = rem >> 7;
        const int row = rt * 32 + l32, b = row >> 6, nb = (row >> 1) & 31, g = row & 1;
        const bf16r* arow = P + (size_t)(b * SEQ + nb * 64) * LDP + PC_BKV + (kind ? 256 : 0) + g * 128;
        const float* pos = p.in[14] + (size_t)(layer * 2 + kind) * 64 * 128;
        const bf16r* brow = W1T + (size_t)kind * 128 * 8192 + (size_t)(nt * 32 + l32) * 8192;
        f32x16 acc = {};
#pragma unroll 4
        for (int s = 0; s < 16; ++s) { const int k = kc * 256 + s * 16 + hi * 8, l = k >> 7, d = k & 127;
            const u32x4 aw = *(const u32x4*)(arow + (size_t)l * LDP + d); const f32x4 p0 = *(const f32x4*)(pos + l * 128 + d), p1 = *(const f32x4*)(pos + l * 128 + d + 4);
            u32x4 a2; a2.x = pk2(__uint_as_float(aw.x << 16) + p0.x, __uint_as_float(aw.x & 0xffff0000u) + p0.y); a2.y = pk2(__uint_as_float(aw.y << 16) + p0.z, __uint_as_float(aw.y & 0xffff0000u) + p0.w);
            a2.z = pk2(__uint_as_float(aw.z << 16) + p1.x, __uint_as_float(aw.z & 0xffff0000u) + p1.y); a2.w = pk2(__uint_as_float(aw.w << 16) + p1.z, __uint_as_float(aw.w & 0xffff0000u) + p1.w);
            const bf16x8 bv = *(const bf16x8*)(brow + k);
            acc = __builtin_amdgcn_mfma_f32_32x32x16_bf16(__builtin_bit_cast(bf16x8, a2), bv, acc, 0, 0, 0); }
        float* out = CPART + ((size_t)(kind * 32 + kc) * 256 + rt * 32) * 128 + nt * 32 + l32;
#pragma unroll
        for (int r = 0; r < 16; ++r) out[(size_t)((r & 3) + 8 * (r >> 2) + 4 * hi) * 128] = acc[r];
    }
    if (gw < 16) {
        const float* lf = (const float*)(p.ws + WS_LOGF) + (size_t)gw * SEQ + lane * 32; float* cs = (float*)(p.ws + WS_CUMS) + (size_t)gw * SEQ + lane * 32;
        f32x4 v[8]; float run = 0.f;
#pragma unroll
        for (int j = 0; j < 8; ++j) { v[j] = ((const f32x4*)lf)[j]; v[j].x += run; v[j].y += v[j].x; v[j].z += v[j].y; v[j].w += v[j].z; run = v[j].w; }
        float incl = run;
#pragma unroll
        for (int o = 1; o < 64; o <<= 1) { const float t = __int_as_float(__builtin_amdgcn_ds_bpermute(((lane - o) & 63) << 2, __float_as_int(incl))); if (lane >= o) incl += t; }
        const float off = incl - run;
#pragma unroll
        for (int j = 0; j < 8; ++j) ((f32x4*)cs)[j] = (v[j] + off) * 11.313708498984761f;
    }
}
__device__ __forceinline__ void phase_cmp2(const Params& p, int layer, char* lds, int gw, int NGW, int wave, int lane) {
    const float* CPART = (const float*)(p.ws + WS_CPART); float* hb = (float*)(lds + wave * 512);
    for (int it = gw; it < 512; it += NGW) {
        const int kind = it >> 8, row = it & 255, b = row >> 6, nb = (row >> 1) & 31, g = row & 1;
        float s0 = 0.f, s1 = 0.f;
        for (int kc = 0; kc < 32; ++kc) { const f32x2 v = *(const f32x2*)(CPART + ((size_t)(kind * 32 + kc) * 256 + row) * 128 + 2 * lane); s0 += v.x; s1 += v.y; }
        const float a0 = 0.7978845608028654f * (s0 + 0.044715f * s0 * s0 * s0), a1 = 0.7978845608028654f * (s1 + 0.044715f * s1 * s1 * s1);
        const float t0 = 1.f - 2.f * __builtin_amdgcn_rcpf(1.f + __expf(2.f * a0)), t1 = 1.f - 2.f * __builtin_amdgcn_rcpf(1.f + __expf(2.f * a1));
        LDSW(); hb[2 * lane] = 0.5f * s0 * (1.f + t0); hb[2 * lane + 1] = 0.5f * s1 * (1.f + t1); LDSW();
        const float* w2 = p.in[16] + (size_t)(layer * 2 + kind) * 128 * 128;
        float o0 = 0.f, o1 = 0.f;
#pragma unroll 8
        for (int n = 0; n < 128; ++n) { const float hv = hb[n]; o0 += hv * w2[n * 128 + lane]; o1 += hv * w2[n * 128 + lane + 64]; }
        if (kind == 0) { const float* gn = p.in[13] + layer * 384; const float r = rsqrtf(wsum(o0 * o0 + o1 * o1, lane) * (1.f / 128.f) + EPS); o0 = o0 * r * gn[lane]; o1 = o1 * r * gn[lane + 64]; }
        float* dst = (float*)(p.ws + (kind ? WS_VC : WS_KC)) + ((size_t)(b * 2 + g) * 32 + nb) * 128;
        dst[lane] = o0; dst[lane + 64] = o1;
    }
}
__device__ __forceinline__ void phase_cmpattn(const Params& p, char* lds, int bid, int G, int tid, int wave, int lane) {
    const bf16r* P = (const bf16r*)(p.ws + WS_P); bf16r* OCMP = (bf16r*)(p.ws + WS_OCMP); unsigned* SELM = (unsigned*)(p.ws + WS_SELM);
    float* kcT = (float*)lds;
    float* vcs = (float*)(lds + 16384);
    float* qf = (float*)(lds + 32768 + wave * 2048);
    float* pw = (float*)(lds + 49152 + wave * 512);
    const int n = lane & 31, hp = lane >> 5;
    for (int item = bid; item < 256; item += G) {
        const int bg = item >> 5, blk = item & 31, b = bg >> 1, g = bg & 1;
        __syncthreads();
        const float* KC = (const float*)(p.ws + WS_KC) + (size_t)bg * 4096; const float* VC = (const float*)(p.ws + WS_VC) + (size_t)bg * 4096;
        for (int i = tid; i < 4096; i += NTHR) { kcT[(i & 127) * 32 + (i >> 7)] = KC[i]; vcs[i] = VC[i]; }
        __syncthreads();
        const int qh_ = lane >> 4, qd0_ = (lane & 15) * 8;
        const bf16r* qsrc_ = P + ((size_t)b * SEQ + blk * 64 + wave * 8) * LDP + PC_BQ + (g * 4 + qh_) * 128 + qd0_;
        u32x4 wnext = *(const u32x4*)qsrc_;
        for (int i = 0; i < 8; ++i) {
            const int t = blk * 64 + wave * 8 + i; const size_t tok = (size_t)b * SEQ + t;
            const u32x4 wcur = wnext; if (i + 1 < 8) wnext = *(const u32x4*)(qsrc_ + (size_t)(i + 1) * LDP);
            const int cur = t >> 6, nvalid = (t + 1) >> 6;
            { const int h = qh_, d0 = qd0_; const u32x4 w = wcur;
              f32x4 a, c; a.x = __uint_as_float(w.x << 16); a.y = __uint_as_float(w.x & 0xffff0000u); a.z = __uint_as_float(w.y << 16); a.w = __uint_as_float(w.y & 0xffff0000u);
              c.x = __uint_as_float(w.z << 16); c.y = __uint_as_float(w.z & 0xffff0000u); c.z = __uint_as_float(w.w << 16); c.w = __uint_as_float(w.w & 0xffff0000u);
              LDSW(); *(f32x4*)(qf + h * 128 + d0) = a; *(f32x4*)(qf + h * 128 + d0 + 4) = c; LDSW(); }
            float s0 = 0.f, s1 = 0.f;
            const float* q0 = qf + (2 * hp) * 128; const float* q1 = q0 + 128;
#pragma unroll 4
            for (int d = 0; d < 128; d += 4) { const f32x4 a = *(const f32x4*)(q0 + d), c = *(const f32x4*)(q1 + d);
                const float k0 = kcT[d * 32 + n], k1 = kcT[(d + 1) * 32 + n], k2 = kcT[(d + 2) * 32 + n], k3 = kcT[(d + 3) * 32 + n];
                s0 += a.x * k0 + a.y * k1 + a.z * k2 + a.w * k3; s1 += c.x * k0 + c.y * k1 + c.z * k2 + c.w * k3; }
            const bool valid = n < nvalid; const float NEG = -1e30f;
            s0 = valid ? s0 * 0.08838834764831845f : NEG; s1 = valid ? s1 * 0.08838834764831845f : NEG;
            float m0 = s0, m1 = s1;
#pragma unroll
            for (int o = 1; o < 32; o <<= 1) { m0 = fmaxf(m0, shx(m0, o, lane)); m1 = fmaxf(m1, shx(m1, o, lane)); }
            float e0 = valid ? __expf(s0 - m0) : 0.f, e1 = valid ? __expf(s1 - m1) : 0.f;
            const float z0 = hsum32(e0, lane), z1 = hsum32(e1, lane);
            const float p0 = nvalid > 0 ? e0 / z0 : 0.f, p1 = nvalid > 0 ? e1 / z1 : 0.f;
            float imp = p0 + p1; imp += shx(imp, 32, lane);
            *(f32x2*)(pw + n * 4 + 2 * hp) = (f32x2){p0, p1};
            const bool forced = (n == 0) || (n == cur) || (n == cur - 1);
            const float score = forced ? 1e4f : (n <= cur ? imp : -1.f);
            int rank = 0;
#pragma unroll
            for (int m = 0; m < 32; ++m) { const float sm = __int_as_float(__builtin_amdgcn_readlane(__float_as_int(score), m)); rank += (sm > score || (sm == score && m < n)) ? 1 : 0; }
            const unsigned long long bal = __builtin_amdgcn_ballot_w64(rank < 8);
            if (lane == 0) SELM[(size_t)bg * SEQ + t] = (unsigned)(bal & 0xffffffffull);
            LDSW();
            float o[4][2] = {};
            for (int m = 0; m < nvalid; ++m) { const f32x2 v = *(const f32x2*)(vcs + m * 128 + 2 * lane); const f32x4 ph = *(const f32x4*)(pw + m * 4);
                o[0][0] += ph.x * v.x; o[0][1] += ph.x * v.y; o[1][0] += ph.y * v.x; o[1][1] += ph.y * v.y; o[2][0] += ph.z * v.x; o[2][1] += ph.z * v.y; o[3][0] += ph.w * v.x; o[3][1] += ph.w * v.y; }
#pragma unroll
            for (int h = 0; h < 4; ++h) *((unsigned*)(OCMP + tok * 1024 + (g * 4 + h) * 128) + lane) = pk2(o[h][0], o[h][1]);
        }
    }
}
__device__ __forceinline__ void phase_combine(const Params& p, int layer, int gw, int NGW, int lane) {
    const bf16r* P = (const bf16r*)(p.ws + WS_P); const unsigned* RDA = (const unsigned*)(p.ws + WS_RDA); const unsigned* RSEL = (const unsigned*)(p.ws + WS_RSEL);
    const unsigned* RWIN = (const unsigned*)(p.ws + WS_RWIN); const unsigned* OCMP = (const unsigned*)(p.ws + WS_OCMP);
    unsigned* OA = (unsigned*)(p.ws + WS_OA);
    const float* lp = p.in[10] + layer * 256; const float* og = p.in[11] + layer * 128;
    const float lam_init = 0.8f - 0.6f * __expf(-0.3f * (float)layer);
    const float lam = __expf(wsum(lp[lane] * lp[64 + lane], lane)) - __expf(wsum(lp[128 + lane] * lp[192 + lane], lane)) + lam_init;
    const float g0 = og[2 * lane] * (1.f - lam_init), g1 = og[2 * lane + 1] * (1.f - lam_init);
    for (int tok0 = gw; tok0 < T; tok0 += 2 * NGW) {
        const int tok1 = (tok0 + NGW < T) ? tok0 + NGW : tok0;
        unsigned da[2][8], oc[2][8], rs[2][8], rw[2][8]; float gl[2];
#pragma unroll
        for (int q = 0; q < 2; ++q) { const int tok = q ? tok1 : tok0;
#pragma unroll
            for (int i = 0; i < 8; ++i) da[q][i] = RDA[(size_t)tok * 512 + i * 64 + lane];
#pragma unroll
            for (int i = 0; i < 8; ++i) { oc[q][i] = OCMP[(size_t)tok * 512 + i * 64 + lane]; rs[q][i] = RSEL[(size_t)tok * 512 + i * 64 + lane]; rw[q][i] = RWIN[(size_t)tok * 512 + i * 64 + lane]; }
            gl[q] = bf2f((P + (size_t)tok * LDP + PC_BG)[lane < 24 ? lane : 0]); }
#pragma unroll
        for (int q = 0; q < 2; ++q) { const int tok = q ? tok1 : tok0; const float glq = pg8::sigmoidf_(gl[q]);
            unsigned oa[4], ob[8];
#pragma unroll
            for (int h = 0; h < 4; ++h) { const unsigned a = da[q][2 * h], c = da[q][2 * h + 1];
                const float v0 = __uint_as_float(a << 16) - lam * __uint_as_float(c << 16), v1 = __uint_as_float(a & 0xffff0000u) - lam * __uint_as_float(c & 0xffff0000u);
                const float r = rsqrtf(wsum(v0 * v0 + v1 * v1, lane) * (1.f / 128.f) + EPS);
                oa[h] = pk2(v0 * r * g0, v1 * r * g1); }
#pragma unroll
            for (int h = 0; h < 8; ++h) {
                const float ga = __int_as_float(__builtin_amdgcn_readlane(__float_as_int(glq), h * 3)), gb = __int_as_float(__builtin_amdgcn_readlane(__float_as_int(glq), h * 3 + 1)), gc = __int_as_float(__builtin_amdgcn_readlane(__float_as_int(glq), h * 3 + 2));
                const unsigned a = oc[q][h], c = rs[q][h], e = rw[q][h];
                const float v0 = ga * __uint_as_float(a << 16) + gb * __uint_as_float(c << 16) + gc * __uint_as_float(e << 16);
                const float v1 = ga * __uint_as_float(a & 0xffff0000u) + gb * __uint_as_float(c & 0xffff0000u) + gc * __uint_as_float(e & 0xffff0000u);
                ob[h] = pk2(v0, v1); }
#pragma unroll
            for (int h = 0; h < 4; ++h) OA[(size_t)tok * 1024 + h * 64 + lane] = oa[h];
#pragma unroll
            for (int h = 0; h < 8; ++h) OA[(size_t)tok * 1024 + 256 + h * 64 + lane] = ob[h]; }
    }
}
#ifndef MK_SPLIT
#define MK_SPLIT 0
#endif
template <int MODE> __device__ __forceinline__ att::BlockRef att_ref(const Params& p, int idx) {
    constexpr int NBH = (MODE == att::M_FOX) ? 16 : 32, NH = NBH / 4;
    const int qb = 7 - idx / NBH, bh = idx % NBH, b = bh / NH, h = bh % NH;
    const att::bf16* P = (const att::bf16*)(p.ws + WS_P);
    const size_t tok0 = (size_t)b * SEQ + qb * 256, tokb = (size_t)b * SEQ;
    att::BlockRef r; r.P0 = qb * 256; r.cks = nullptr; r.sel = nullptr;
    if (MODE == att::M_DA) { r.Q = P + tok0 * LDP + PC_AQ + h * 64; r.K = P + tokb * LDP + PC_AK + h * 64; r.V = P + tokb * LDP + PC_AV + (h >> 1) * 128;
        r.O = (att::bf16*)(p.ws + WS_RDA) + tok0 * 1024 + h * 128; r.ldo = 1024; }
    else if (MODE == att::M_FOX) { r.Q = P + tok0 * LDP + PC_CQ + h * 128; r.K = P + tokb * LDP + PC_CK + h * 128; r.V = P + tokb * LDP + PC_CV + h * 128;
        r.O = (att::bf16*)(p.ws + WS_OA) + tok0 * 2048 + 1536 + h * 128; r.ldo = 2048; r.cks = (const float*)(p.ws + WS_CUMS) + (size_t)(b * 4 + h) * SEQ; }
    else if (MODE == att::M_SEL) { const int g = h >> 2; r.Q = P + tok0 * LDP + PC_BQ + h * 128; r.K = P + tokb * LDP + PC_BKV + 512 + g * 128; r.V = P + tokb * LDP + PC_BKV + 768 + g * 128;
        r.O = (att::bf16*)(p.ws + WS_RSEL) + tok0 * 1024 + h * 128; r.ldo = 1024; r.sel = (const unsigned*)(p.ws + WS_SELM) + (size_t)(b * 2 + g) * SEQ; }
    else { const int g = h >> 2; r.Q = P + tok0 * LDP + PC_BQ + h * 128; r.K = P + tokb * LDP + PC_BKV + 1024 + g * 128; r.V = P + tokb * LDP + PC_BKV + 1280 + g * 128;
        r.O = (att::bf16*)(p.ws + WS_RWIN) + tok0 * 1024 + h * 128; r.ldo = 1024; }
    return r;
}
__device__ __forceinline__ int q_fetch(unsigned* ctr, char* lds, int tid) {
    volatile __attribute__((address_space(3))) int* slot = (volatile __attribute__((address_space(3))) int*)((__attribute__((address_space(3))) char*)lds + LDS_SLOT);
    if (tid == 0) *slot = (int)atomicAdd(ctr, 1u);
    __syncthreads();
    const int v = *slot;
    return __builtin_amdgcn_readfirstlane(v);
}
template <int MODE> __device__ __forceinline__ void att_mode(const Params& p, unsigned* ctr, char* lds, int tid_in) {
    int tid = tid_in; asm volatile("" : "+v"(tid));
    constexpr int TOTAL = (MODE == att::M_FOX) ? 128 : 256;
    const int W = (MODE == att::M_WIN) ? 512 : (1 << 20);
    int idx = q_fetch(ctr, lds, tid);
    if (idx >= TOTAL) return;
    att::BlockRef cur = att_ref<MODE>(p, idx); att::Seam S;
    att::att_prime<MODE>(cur, W, lds, S, tid);
    for (;;) {
        const int nidx = q_fetch(ctr, lds, tid); const bool last = nidx >= TOTAL;
        const att::BlockRef nxt = last ? cur : att_ref<MODE>(p, nidx);
        att::att_block<MODE>(cur, nxt, SEQ, W, lds, S, tid);
        if (last) break;
        cur = nxt;
    }
}
#define LAS __attribute__((address_space(3)))
#define XB_TMO      128
#define XB_XCNT(j)  (256  + 64 * (j))
#define XB_XSUB(j)  (1280 + 64 * (j))
#define XB_XGEN(j)  (2304 + 64 * (j))
#define XB_TOP      3328
#define XB_TOPGEN   3392
#define XCD_BAR_WORDS 3456
#define XB_SPIN_CAP (1u << 18)

__device__ __forceinline__ unsigned xb_ld(unsigned* p)              { return __hip_atomic_load(p, __ATOMIC_RELAXED, __HIP_MEMORY_SCOPE_AGENT); }
__device__ __forceinline__ unsigned xb_add(unsigned* p, unsigned v) { return __hip_atomic_fetch_add(p, v, __ATOMIC_RELAXED, __HIP_MEMORY_SCOPE_AGENT); }
__device__ __forceinline__ unsigned xb_xcc_id() { return (unsigned)__builtin_amdgcn_s_getreg((3 << 11) | 20) & 0xFu; }
#define XB_SPIN(cond, bar) do { unsigned _sp = 0; while (cond) { __builtin_amdgcn_s_sleep(1); \
    if ((++_sp & 255u) == 0u) { if (xb_ld(&(bar)[XB_TMO])) break; if (_sp > XB_SPIN_CAP) { atomicAdd(&(bar)[XB_TMO], 1u); break; } } } } while (0)

struct XcdBarrier {
    unsigned* bar; unsigned x;
    volatile LAS unsigned* st;
};

__device__ __forceinline__ XcdBarrier xcd_barrier_post(unsigned* bar, volatile LAS unsigned* st) {
    XcdBarrier b; b.bar = bar; b.x = xb_xcc_id(); b.st = st;
    if (threadIdx.x == 0) (void)xb_add(&bar[XB_XCNT(b.x)], 1u);
    return b;
}
__device__ __forceinline__ void xcd_barrier_complete(unsigned* bar, unsigned x, unsigned& nloc, unsigned& nx) {
    const unsigned G = gridDim.x * gridDim.y * gridDim.z;
    unsigned sum, cnt, mine, sp = 0u;
    for (;;) {
        sum = 0u; cnt = 0u; mine = 0u;
#pragma unroll
        for (unsigned j = 0; j < 16; ++j) { const unsigned c = xb_ld(&bar[XB_XCNT(j)]); sum += c; cnt += (c > 0u) ? 1u : 0u; mine = (j == x) ? c : mine; }
        if (sum == G) break;
        __builtin_amdgcn_s_sleep(1);
        if ((++sp & 255u) == 0u) { if (xb_ld(&bar[XB_TMO])) break; if (sp > XB_SPIN_CAP) { atomicAdd(&bar[XB_TMO], 1u); break; } }
    }
    nloc = mine > 0u ? mine : 1u; nx = cnt > 0u ? cnt : 1u;
}

__device__ __forceinline__ void xcd_barrier(const XcdBarrier& b) {
    asm volatile("s_waitcnt vmcnt(0)" ::: "memory");
    __syncthreads();
    if (threadIdx.x == 0) {
        unsigned* bar = b.bar;
        __builtin_amdgcn_s_waitcnt(0);
        unsigned nloc = b.st[0], nx = b.st[1];
        if (nloc == 0u) { xcd_barrier_complete(bar, b.x, nloc, nx); b.st[0] = nloc; b.st[1] = nx; }
        const unsigned old = xb_add(&bar[XB_XSUB(b.x)], 1u);
        const unsigned gen = old / nloc;
        if (old + 1u == (gen + 1u) * nloc) {
            __builtin_amdgcn_fence(__ATOMIC_RELEASE, "agent");
            asm volatile("s_waitcnt vmcnt(0)" ::: "memory");
            const unsigned og = xb_add(&bar[XB_TOP], 1u);
            const unsigned tg = og / nx;
            if (og + 1u == (tg + 1u) * nx) xb_add(&bar[XB_TOPGEN], 1u);
            else XB_SPIN(xb_ld(&bar[XB_TOPGEN]) == tg, bar);
            __builtin_amdgcn_fence(__ATOMIC_ACQUIRE, "agent");
            xb_add(&bar[XB_XGEN(b.x)], 1u);
            asm volatile("s_waitcnt vmcnt(0)" ::: "memory");
        } else {
            XB_SPIN(xb_ld(&bar[XB_XGEN(b.x)]) == gen, bar);
            __builtin_amdgcn_fence(__ATOMIC_ACQUIRE, "agent");
            asm volatile("s_waitcnt vmcnt(0)" ::: "memory");
        }
    }
    __syncthreads();
}

constexpr int CW_BAR = 4096;
constexpr int LDS_BARST = 140032;
constexpr int PH_PER_LAYER = 13, N_PHASES = PH_PER_LAYER * DEPTH;
typedef const Params __attribute__((address_space(4)))* KP;
template <int KS> __device__ __forceinline__ void phase_body(const int ph, char* lds, pg8::PG8_LAS_T ldsg, const int wave_s, const XcdBarrier& bar, const int rep) {
        KP kp = (KP)__builtin_amdgcn_kernarg_segment_ptr(); asm volatile("" : "+s"(kp));
        const Params& p = *(const Params*)kp;
        int bid = blockIdx.x; asm volatile("" : "+s"(bid));
        int G = gridDim.x; asm volatile("" : "+s"(G)); const int NGW = G * NWAVES;
        unsigned char* ws = p.ws;
        unsigned* ctl = (unsigned*)(ws + WS_CTL);
        bf16r* H = (bf16r*)(ws + WS_H); bf16r* P = (bf16r*)(ws + WS_P); bf16r* ACT = (bf16r*)(ws + WS_P);
        const int layer = ph / PH_PER_LAYER, k = ph - layer * PH_PER_LAYER;
        int tid; asm volatile("v_mbcnt_lo_u32_b32 %0, -1, 0\n\tv_mbcnt_hi_u32_b32 %0, -1, %0" : "=v"(tid)); tid += wave_s * 64;
        const int lane = tid & 63, wave = __builtin_amdgcn_readfirstlane(tid >> 6), gw = bid * NWAVES + wave;
        const float* xin = (layer == 0) ? p.in[0] : p.out;
        {
        if constexpr (KS < 0 || KS == 0) if (k == 0) {
            if (ph == 0) { if (bid == 0 && tid < 32) ctl[64 * tid] = 0u;
                unsigned long long* rz = (unsigned long long*)(ws + WS_RS) + T; for (int i = bid * NTHR + tid; i < 6 * T; i += G * NTHR) rz[i] = 0ull;
                phase_rms(xin, p.in[2], H, (unsigned long long*)(ws + WS_RS), gw, NGW, lane); }
            phase_convert(p, layer, lds, gw, NGW, wave, lane);
        }
        if constexpr (KS < 0 || KS == 1 || KS == 11) if (k == 1 || k == 11) {
            pg8::Gemm g{H, (const bf16r*)(ws + (k == 1 ? WS_WGU1 : WS_WGU2)), T, 2 * FF, DM}; pg8::StaticOrder S; S.init(T, 2 * FF, G, bid);
            pg8::EpiGU E{ACT, FF, (const unsigned long long*)(ws + WS_RS) + (size_t)(layer * 3 + (k == 1 ? 0 : 2)) * T};
            pg8::gemm_phase<pg8::EpiGU, pg8::StaticOrder, true, true>(ldsg, g, S, E, tid);
        }
        if constexpr (KS < 0 || KS == 2 || KS == 12 || KS == 10) if (k == 2 || k == 12 || k == 10) {
            const bf16r* A = (k == 10) ? (const bf16r*)(ws + WS_YBF) : ACT; const bf16r* B = (const bf16r*)(ws + (k == 2 ? WS_WD1 : (k == 12 ? WS_WD2 : WS_WO)));
            pg8::Gemm g{A, B, T, DM, (k == 10) ? DM : FF}; pg8::StaticOrder S; S.init(T, DM, G, bid);
            const int nl = (layer + 1 < DEPTH) ? layer + 1 : layer;
            const float* gn = (k == 2) ? p.in[6] + layer * DM : (k == 10 ? p.in[24] + layer * DM : p.in[2] + nl * DM);
            unsigned long long* rsn = (unsigned long long*)(ws + WS_RS) + (size_t)(k == 2 ? layer * 3 + 1 : (k == 10 ? layer * 3 + 2 : layer * 3 + 3)) * T;
            if (k == 10) { pg8::EpiRes<0> E{(const float*)p.out, p.out, gn, H, rsn}; pg8::gemm_phase<pg8::EpiRes<0>, pg8::StaticOrder, true, true>(ldsg, g, S, E, tid); }
            else { pg8::EpiRes<1> E{(k == 2) ? xin : (const float*)p.out, p.out, gn, H, rsn}; pg8::gemm_phase<pg8::EpiRes<1>, pg8::StaticOrder, true, true>(ldsg, g, S, E, tid); }
        }
        if constexpr (KS < 0 || KS == 3) if (k == 3) {
            pg8::Gemm g{H, (const bf16r*)(ws + WS_WIN), T, LDP, DM}; pg8::StaticOrder S; S.init(T, LDP, G, bid);
            pg8::EpiP E{P, LDP, (const unsigned long long*)(ws + WS_RS) + (size_t)(layer * 3 + 1) * T};
            pg8::gemm_phase<pg8::EpiP, pg8::StaticOrder, true, true>(ldsg, g, S, E, tid);
        }
        if constexpr (KS < 0 || KS == 4) if (k == 4) { phase_prep(p, layer, gw, NGW, lane); }
        if constexpr (KS < 0 || KS == 5) if (k == 5) { phase_cmp1(p, layer, gw, NGW, lane); }
        if constexpr (KS < 0 || KS == 6) if (k == 6) { phase_cmp2(p, layer, lds, gw, NGW, wave, lane); }
        if constexpr (KS < 0 || KS == 7) if (k == 7) { phase_cmpattn(p, lds, bid, G, tid, wave, lane); }
        if constexpr (KS < 0 || KS == 8) if (k == 8) {
            unsigned* c = ctl + 64 * (layer * 4 + rep * 8);

#ifndef ATTMASK
#define ATTMASK 15
#endif
#ifndef PROBE_ATT
#define PROBE_ATT 15
#endif
#if ATTMASK & 1
            if (rep == 0 || (PROBE_ATT & 1)) att_mode<att::M_DA>(p, c, lds, tid);
#endif
#if ATTMASK & 2
            if (rep == 0 || (PROBE_ATT & 2)) att_mode<att::M_SEL>(p, c + 64, lds, tid);
#endif
#if ATTMASK & 4
            if (rep == 0 || (PROBE_ATT & 4)) att_mode<att::M_FOX>(p, c + 128, lds, tid);
#endif
#if ATTMASK & 8
            if (rep == 0 || (PROBE_ATT & 8)) att_mode<att::M_WIN>(p, c + 192, lds, tid);
#endif

        }
        if constexpr (KS < 0 || KS == 9) if (k == 9) {
#ifndef MM
#define MM 15
#endif
#if MM & 1
            phase_combine(p, layer, gw, NGW, lane);
            xcd_barrier(bar);
#endif
            pg8::StaticOrder S; S.init(T, DM, G, bid);
            { pg8::Gemm g{(const bf16r*)(ws + WS_OA), (const bf16r*)(ws + WS_WA), T, DM, DM}; pg8::EpiMergeH E{P, LDP, PC_GM, (bf16r*)(ws + WS_YBF), DM};
              pg8::gemm_phase<pg8::EpiMergeH, pg8::StaticOrder, true, true>(ldsg, g, S, E, tid); }
        }
        }
}
template <int KS, int PH> struct Runner {
    static __device__ __forceinline__ void run(char* lds, pg8::PG8_LAS_T ldsg, const int wave_s, cg::grid_group& grid, const XcdBarrier& bar) {
        phase_body<KS>(PH, lds, ldsg, wave_s, bar, 0);
#ifdef PROBE_PH
        if constexpr (PH == PROBE_PH) { xcd_barrier(bar); phase_body<KS>(PH, lds, ldsg, wave_s, bar, 1); }
#endif
#ifdef PROBE_DUP
        if constexpr ((PROBE_DUP >> (PH % PH_PER_LAYER)) & 1) { xcd_barrier(bar); phase_body<KS>(PH, lds, ldsg, wave_s, bar, 1); }
#endif
        if constexpr (PH + 1 < N_PHASES) {
            xcd_barrier(bar);
            Runner<KS, PH + 1>::run(lds, ldsg, wave_s, grid, bar); }
    }
};
template <int KS> __global__ void __launch_bounds__(NTHR, 2) mega_fwd(Params p_arg) {
    extern __shared__ __attribute__((aligned(16))) unsigned char lds_raw[];
    char* lds = (char*)lds_raw;
    pg8::PG8_LAS_T ldsg = (pg8::PG8_LAS_T)lds_raw;
    cg::grid_group grid = cg::this_grid();
    const int wave_s = __builtin_amdgcn_readfirstlane(threadIdx.x >> 6);
    volatile LAS unsigned* st = (volatile LAS unsigned*)((LAS unsigned char*)lds_raw + LDS_BARST);
    if (threadIdx.x < 2) st[threadIdx.x] = 0u;
    __syncthreads();
    const XcdBarrier bar = xcd_barrier_post((unsigned*)(p_arg.ws + WS_CTL) + CW_BAR, st);
    if constexpr (KS < 0) { if (p_arg.ph_hi < 0) grid.sync();
        Runner<KS, 0>::run(lds, ldsg, wave_s, grid, bar); }
    else { const int ph_lo = p_arg.ph_lo, ph_hi = p_arg.ph_hi;
        for (int ph = ph_lo; ph < ph_hi; ++ph) { phase_body<KS>(ph, lds, ldsg, wave_s, bar, 0); if (ph + 1 < ph_hi) grid.sync(); } }
}
template <int KS> static const void* kfn() { return (const void*)mega_fwd<KS>; }
static const void* kfn_of(int k) {
#if MK_SPLIT
    switch (k) { case 0: return kfn<0>(); case 1: case 11: return kfn<1>(); case 2: case 12: case 10: return kfn<2>(); case 3: return kfn<3>();
        case 4: return kfn<4>(); case 5: return kfn<5>(); case 6: return kfn<6>(); case 7: return kfn<7>(); case 8: return kfn<8>(); default: return kfn<9>(); }
#else
    (void)k; return kfn<-1>();
#endif
}
extern "C" void kernel_launch(void* const* d_in, const int* in_sizes, int n_in, void* d_out, int out_size, void* d_ws, size_t ws_size, hipStream_t stream) {
    static int grid = 0;
    if (grid == 0) {
        if (n_in != 28 || out_size != T * DM || ws_size < WS_END) { fprintf(stderr, "kernel_launch: unexpected shapes (n_in %d out %d ws %zu need %zu)\n", n_in, out_size, ws_size, (size_t)WS_END); grid = -1; return; }
        int dev = 0, cus = 0;
        (void)hipGetDevice(&dev); (void)hipDeviceGetAttribute(&cus, hipDeviceAttributeMultiprocessorCount, dev);
        for (int k = 0; k < PH_PER_LAYER; ++k)
            if (hipFuncSetAttribute(kfn_of(k), hipFuncAttributeMaxDynamicSharedMemorySize, LDS_BYTES) != hipSuccess) { fprintf(stderr, "hipFuncSetAttribute failed\n"); grid = -1; return; }
        int per_cu = 0;
        if (hipOccupancyMaxActiveBlocksPerMultiprocessor(&per_cu, kfn_of(8), NTHR, LDS_BYTES) != hipSuccess || per_cu < 1) fprintf(stderr, "occupancy query: %d\n", per_cu);
        (void)hipGetLastError();
        grid = cus > 0 ? cus : 256;
    }
    if (grid < 0) return;
    if (hipMemsetAsync(d_ws, 0, 65536, stream) != hipSuccess) { fprintf(stderr, "memset failed\n"); return; }
    Params p{};
    for (int i = 0; i < 28; ++i) p.in[i] = (const float*)d_in[i];
    p.out = (float*)d_out; p.ws = (unsigned char*)d_ws;
#if MK_SPLIT
    for (int ph = 0; ph < N_PHASES; ++ph) { p.ph_lo = ph; p.ph_hi = ph + 1; void* args[] = {&p};
        hipError_t e = hipLaunchCooperativeKernel(kfn_of(ph % PH_PER_LAYER), dim3(grid), dim3(NTHR), args, LDS_BYTES, stream);
        if (e != hipSuccess) { fprintf(stderr, "launch %d failed: %s\n", ph, hipGetErrorString(e)); break; } }
#else
    p.ph_lo = 0; p.ph_hi = N_PHASES; void* args[] = {&p};
    hipError_t e = hipLaunchCooperativeKernel(kfn_of(0), dim3(grid), dim3(NTHR), args, LDS_BYTES, stream);
    if (e != hipSuccess) fprintf(stderr, "cooperative launch failed: %s (grid %d)\n", hipGetErrorString(e), grid);
#endif
}
```

```cpp
#include <hip/hip_runtime.h>
#include <hip/hip_bf16.h>
#include <hip/hip_cooperative_groups.h>
#include <cstdio>
#include <cstdint>
namespace cg = cooperative_groups;
namespace pg8 {
#define PG8_LAS __attribute__((address_space(3)))
typedef unsigned short bf16_t;
typedef short bf16x8 __attribute__((ext_vector_type(8)));
typedef float f32x4 __attribute__((ext_vector_type(4)));
typedef unsigned u32x4 __attribute__((ext_vector_type(4)));
constexpr int BM = 256, BK = 64, HALF = 128, HTB = HALF * BK * 2  , STAGE_BYTES = 8 * HTB, NXCD = 8, WGM = 4;

__host__ __device__ __forceinline__ int lds_byte(int r, int c) { const int st = (r >> 4) * 2 + (c >> 5), rr = r & 15, cc = c & 31, ob = rr * 64 + cc * 2; return st * 1024 + (ob ^ (((ob >> 9) & 1) << 5)); }
__host__ __device__ __forceinline__ void stage_rc(int b, int& R, int& C) { const int st = b / 1024, sb = b % 1024, swz = sb ^ (((sb >> 9) & 1) << 5); R = (st >> 1) * 16 + swz / 64; C = (st & 1) * 32 + (swz % 64) / 2; }
__host__ __device__ __forceinline__ int perm32(int rho) { const int n = rho >> 4, i = rho & 15; return 8 * (i >> 2) + 4 * n + (i & 3); }

struct Unit { int pm, pn; };
struct Gemm { const bf16_t* A; const bf16_t* Bt; int M, N, K; };

struct StaticOrder {
    int nM, nN, nwg, G, c;
    __host__ __device__ void init(int M, int N, int G_, int c_) { nM = M / BM; nN = N / BM; nwg = nM * nN; G = G_; c = c_; }
    __host__ __device__ bool next(int i, Unit& u) const {
        const long L = (long)i * G + c; if (L >= nwg) return false;
        int wgid = (int)L; { const int q = nwg / NXCD, r = nwg % NXCD, xcd = wgid % NXCD, off = wgid / NXCD; wgid = (xcd < r ? xcd * (q + 1) : r * (q + 1) + (xcd - r) * q) + off; }
        const int nig = WGM * nN, gid = wgid / nig, fm = gid * WGM, gsz = (nM - fm) < WGM ? (nM - fm) : WGM;
        u.pm = fm + ((wgid % nig) % gsz); u.pn = (wgid % nig) / gsz; return true;
    }
    __device__ __forceinline__ void a_ready(const Unit&) const {}
    __device__ __forceinline__ void done(const Unit&) const {}
};

__device__ __forceinline__ unsigned cvt_pk_bf16(float lo, float hi) { unsigned r; asm volatile("v_cvt_pk_bf16_f32 %0, %1, %2" : "=v"(r) : "v"(lo), "v"(hi)); return r; }
typedef unsigned u32x2 __attribute__((ext_vector_type(2)));
__device__ __forceinline__ float sigmoidf_(float v) { return __builtin_amdgcn_rcpf(1.f + __expf(-v)); }
__device__ __forceinline__ float bf2f(unsigned short h) { return __uint_as_float(((unsigned)h) << 16); }
struct EpiGU {
    static constexpr bool PERM = true, AFTER_DRAIN = false, HOOK = false;
    bf16_t* O; int ldc; const unsigned long long* rss;
    __device__ __forceinline__ void operator()(const f32x4 (&acc)[2][2][4][2], const Unit& u, int wr, int wc, int fr, int fq) const {
        const int row0 = u.pm * BM + wr * 64 + fr, col0 = u.pn * HALF + wc * 32 + 8 * fq;
#pragma unroll
        for (int ai = 0; ai < 2; ++ai)
#pragma unroll
            for (int m = 0; m < 4; ++m) { bf16_t* rowp = O + (size_t)(row0 + ai * HALF + m * 16) * ldc + col0;
                const float rs = rsqrtf((float)rss[row0 + ai * HALF + m * 16] * (1.f / (65536.f * 2048.f)) + 1e-6f);
                float r[8];
#pragma unroll
                for (int n = 0; n < 2; ++n)
#pragma unroll
                    for (int j = 0; j < 4; ++j) { const float g = acc[ai][0][m][n][j] * rs, uu = acc[ai][1][m][n][j] * rs; r[n * 4 + j] = g * sigmoidf_(g) * uu; }
                u32x4 w; w.x = cvt_pk_bf16(r[0], r[1]); w.y = cvt_pk_bf16(r[2], r[3]); w.z = cvt_pk_bf16(r[4], r[5]); w.w = cvt_pk_bf16(r[6], r[7]);
                *(u32x4*)rowp = w; }
    }
};
struct EpiP {
    static constexpr bool PERM = true, AFTER_DRAIN = false, HOOK = false;
    bf16_t* O; int ldc; const unsigned long long* rss;
    __device__ __forceinline__ void operator()(const f32x4 (&acc)[2][2][4][2], const Unit& u, int wr, int wc, int fr, int fq) const {
        const int row0 = u.pm * BM + wr * 64 + fr, col0 = u.pn * BM + wc * 32 + 8 * fq;
#pragma unroll
        for (int ai = 0; ai < 2; ++ai)
#pragma unroll
            for (int m = 0; m < 4; ++m) { bf16_t* rowp = O + (size_t)(row0 + ai * HALF + m * 16) * ldc + col0;
                const float rs = rsqrtf((float)rss[row0 + ai * HALF + m * 16] * (1.f / (65536.f * 2048.f)) + 1e-6f);
#pragma unroll
                for (int bj = 0; bj < 2; ++bj) { const f32x4 v0 = acc[ai][bj][m][0] * rs, v1 = acc[ai][bj][m][1] * rs;
                    u32x4 w; w.x = cvt_pk_bf16(v0[0], v0[1]); w.y = cvt_pk_bf16(v0[2], v0[3]); w.z = cvt_pk_bf16(v1[0], v1[1]); w.w = cvt_pk_bf16(v1[2], v1[3]);
                    *(u32x4*)(rowp + bj * HALF) = w; } }
    }
};
template <int HALFA> struct EpiRes {
    static constexpr bool PERM = false, AFTER_DRAIN = false, HOOK = false;
    const float* src; float* out; const float* gain; bf16_t* hn; unsigned long long* rss;
    __device__ __forceinline__ void operator()(const f32x4 (&acc)[2][2][4][2], const Unit& u, int wr, int wc, int fr, int fq) const {
        constexpr int ldc = 2048; constexpr float alpha = HALFA ? 0.5f : 1.f;
        int row0 = u.pm * BM + wr * 64 + fr, col0 = u.pn * BM + wc * 32 + 4 * fq; asm volatile("" : "+v"(row0), "+v"(col0));
        const int lane = fq * 16 + fr;
#pragma unroll
        for (int ai = 0; ai < 2; ++ai)
#pragma unroll
            for (int m = 0; m < 4; ++m) { const int row = row0 + ai * HALF + m * 16; const size_t off = (size_t)row * ldc + col0; float ss = 0.f;
#pragma unroll
                for (int bj = 0; bj < 2; ++bj)
#pragma unroll
                    for (int n = 0; n < 2; ++n) { const int co = bj * HALF + n * 16; const f32x4 s = *(const f32x4*)(src + off + co);
                        const f32x4 v = s + acc[ai][bj][m][n] * alpha;
                        *(f32x4*)(out + off + co) = v;
                        const f32x4 g = *(const f32x4*)(gain + col0 + co);
                        u32x2 w; w.x = cvt_pk_bf16(v[0] * g[0], v[1] * g[1]); w.y = cvt_pk_bf16(v[2] * g[2], v[3] * g[3]); *(u32x2*)(hn + off + co) = w;
                        ss += (v[0] * v[0] + v[1] * v[1]) + (v[2] * v[2] + v[3] * v[3]); }
                ss += __int_as_float(__builtin_amdgcn_ds_bpermute((lane ^ 16) << 2, __float_as_int(ss)));
                ss += __int_as_float(__builtin_amdgcn_ds_bpermute((lane ^ 32) << 2, __float_as_int(ss)));
                if (fq == 0) __hip_atomic_fetch_add(rss + row, (unsigned long long)(unsigned)(ss * 65536.f + 0.5f), __ATOMIC_RELAXED, __HIP_MEMORY_SCOPE_AGENT);
                if (m == 3) asm volatile("" ::: "memory"); }
    }
};
template <int I> struct EpiMerge {
    static constexpr bool PERM = false, AFTER_DRAIN = false, HOOK = false;
    const bf16_t* G; int ldg; int gcol; float* yacc; bf16_t* ybf; int ldc;
    __device__ __forceinline__ void operator()(const f32x4 (&acc)[2][2][4][2], const Unit& u, int wr, int wc, int fr, int fq) const {
        const int row0 = u.pm * BM + wr * 64 + fr, col0 = u.pn * BM + wc * 32 + 4 * fq;
#pragma unroll
        for (int ai = 0; ai < 2; ++ai)
#pragma unroll
            for (int m = 0; m < 4; ++m) { const int row = row0 + ai * HALF + m * 16; const size_t off = (size_t)row * ldc + col0; const bf16_t* gp = G + (size_t)row * ldg + gcol + col0;
#pragma unroll
                for (int bj = 0; bj < 2; ++bj)
#pragma unroll
                    for (int n = 0; n < 2; ++n) { const int co = bj * HALF + n * 16;
                        const u32x2 gw = *(const u32x2*)(gp + co);
                        f32x4 gt; gt[0] = sigmoidf_(__uint_as_float(gw.x << 16)); gt[1] = sigmoidf_(__uint_as_float(gw.x & 0xffff0000u));
                        gt[2] = sigmoidf_(__uint_as_float(gw.y << 16)); gt[3] = sigmoidf_(__uint_as_float(gw.y & 0xffff0000u));
                        f32x4 v = gt * acc[ai][bj][m][n];
                        if (I > 0) v += *(const f32x4*)(yacc + off + co);
                        if (I < 2) *(f32x4*)(yacc + off + co) = v;
                        else { u32x2 w; w.x = cvt_pk_bf16(v[0], v[1]); w.y = cvt_pk_bf16(v[2], v[3]); *(u32x2*)(ybf + off + co) = w; } }
                asm volatile("" ::: "memory"); }
    }
};

struct EpiMergeH {
    static constexpr bool PERM = false, AFTER_DRAIN = false, HOOK = true;
    const bf16_t* G; int ldg; int gcol; bf16_t* ybf; int ldc;
    __device__ __forceinline__ void hook(f32x4 (&acc)[2][2][4][2], const Unit& u, int wr, int wc, int fr, int fq, int which) const {
        int row0 = u.pm * BM + wr * 64 + fr, col0 = u.pn * BM + wc * 32 + 4 * fq; asm volatile("" : "+v"(row0), "+v"(col0));
#pragma unroll
        for (int ai = 0; ai < 2; ++ai)
#pragma unroll
            for (int m = 0; m < 4; ++m) { const int row = row0 + ai * HALF + m * 16; const bf16_t* gp = G + (size_t)row * ldg + gcol + which * 2048 + col0;
#pragma unroll
                for (int bj = 0; bj < 2; ++bj)
#pragma unroll
                    for (int n = 0; n < 2; ++n) { const int co = bj * HALF + n * 16;
                        const u32x2 ga = *(const u32x2*)(gp + co), gb = *(const u32x2*)(gp + 2048 + co);
                        f32x4 r;
                        r[0] = (1.f + __expf(-__uint_as_float(gb.x << 16))) * __builtin_amdgcn_rcpf(1.f + __expf(-__uint_as_float(ga.x << 16)));
                        r[1] = (1.f + __expf(-__uint_as_float(gb.x & 0xffff0000u))) * __builtin_amdgcn_rcpf(1.f + __expf(-__uint_as_float(ga.x & 0xffff0000u)));
                        r[2] = (1.f + __expf(-__uint_as_float(gb.y << 16))) * __builtin_amdgcn_rcpf(1.f + __expf(-__uint_as_float(ga.y << 16)));
                        r[3] = (1.f + __expf(-__uint_as_float(gb.y & 0xffff0000u))) * __builtin_amdgcn_rcpf(1.f + __expf(-__uint_as_float(ga.y & 0xffff0000u)));
                        acc[ai][bj][m][n] *= r; }
                if (m & 1) asm volatile("" ::: "memory"); }
    }
    __device__ __forceinline__ void operator()(const f32x4 (&acc)[2][2][4][2], const Unit& u, int wr, int wc, int fr, int fq) const {
        const int row0 = u.pm * BM + wr * 64 + fr, col0 = u.pn * BM + wc * 32 + 4 * fq;
#pragma unroll
        for (int ai = 0; ai < 2; ++ai)
#pragma unroll
            for (int m = 0; m < 4; ++m) { const int row = row0 + ai * HALF + m * 16; const size_t off = (size_t)row * ldc + col0; const bf16_t* gp = G + (size_t)row * ldg + gcol + 2 * 2048 + col0;
#pragma unroll
                for (int bj = 0; bj < 2; ++bj)
#pragma unroll
                    for (int n = 0; n < 2; ++n) { const int co = bj * HALF + n * 16;
                        const u32x2 gw = *(const u32x2*)(gp + co);
                        f32x4 gt; gt[0] = sigmoidf_(__uint_as_float(gw.x << 16)); gt[1] = sigmoidf_(__uint_as_float(gw.x & 0xffff0000u));
                        gt[2] = sigmoidf_(__uint_as_float(gw.y << 16)); gt[3] = sigmoidf_(__uint_as_float(gw.y & 0xffff0000u));
                        const f32x4 v = gt * acc[ai][bj][m][n];
                        u32x2 w; w.x = cvt_pk_bf16(v[0], v[1]); w.y = cvt_pk_bf16(v[2], v[3]); *(u32x2*)(ybf + off + co) = w; }
                if (m & 1) asm volatile("" ::: "memory"); }
    }
};
template <class Epi, class Sched, bool ALIGN_EPI = false, bool SP2 = false>
__device__ __forceinline__ void gemm_phase(PG8_LAS unsigned char* lds, const Gemm g, const Sched& S, const Epi& E, int tid_in) {
    const int tid = tid_in, wid = __builtin_amdgcn_readfirstlane(tid >> 6), lane = tid & 63, wr = wid >> 2, wc = wid & 3, fr = lane & 15, fq = lane >> 4;
    const int K = g.K, nt = K / BK;
    unsigned voffA[2], voffB[2];
#pragma unroll
    for (int i = 0; i < 2; ++i) { int R, C; stage_rc(tid * 16 + i * 8192, R, C); const int Rb = Epi::PERM ? ((R & ~31) + perm32(R & 31)) : R;
        voffA[i] = (unsigned)(R * K + C) * 2u; voffB[i] = (unsigned)(Rb * K + C) * 2u; }
    const size_t kstep = (size_t)(BK * 2);
    const size_t hstep = (size_t)HALF * K * 2;
    const size_t tstep = 2 * hstep;
    const unsigned ldsw = (unsigned)wid * 1024u;
    const int aoff = lds_byte(wr * 64 + fr, fq * 8), boff = lds_byte(wc * 32 + fr, fq * 8);
#define PG8_SA(b, h) (((b) * 2 + (h)) * HTB)
#define PG8_SB(b, h) ((4 + (b) * 2 + (h)) * HTB)
#define PG8_STAGE(bufoff, gbase, voff) do { _Pragma("unroll") for (int _i = 0; _i < 2; ++_i) \
        __builtin_amdgcn_global_load_lds((const unsigned*)((const char*)(gbase) + (voff)[_i]), (PG8_LAS unsigned*)(lds + (bufoff) + ldsw + _i * 8192), 16, 0, 0); } while (0)
#define PG8_LDA(dst, b, h) do { _Pragma("unroll") for (int m = 0; m < 4; ++m) _Pragma("unroll") for (int k = 0; k < 2; ++k) dst[m][k] = *(const PG8_LAS bf16x8*)(lds + PG8_SA(b, h) + aoff + m * 2048 + k * 1024); } while (0)
#define PG8_LDB(dst, b, h) do { _Pragma("unroll") for (int n = 0; n < 2; ++n) _Pragma("unroll") for (int k = 0; k < 2; ++k) dst[n][k] = *(const PG8_LAS bf16x8*)(lds + PG8_SB(b, h) + boff + n * 2048 + k * 1024); } while (0)
#define PG8_MMA(ai, bj, At, Bt) do { __builtin_amdgcn_s_setprio(1); _Pragma("unroll") for (int m = 0; m < 4; ++m) _Pragma("unroll") for (int n = 0; n < 2; ++n) _Pragma("unroll") for (int k = 0; k < 2; ++k) \
        acc[ai][bj][m][n] = __builtin_amdgcn_mfma_f32_16x16x32_bf16(Bt[n][k], At[m][k], acc[ai][bj][m][n], 0, 0, 0); __builtin_amdgcn_s_setprio(0); } while (0)
#define PG8_WAIT_V(n) asm volatile("s_waitcnt vmcnt(" #n ")" ::: "memory")
#define PG8_WAIT_L(n) asm volatile("s_waitcnt lgkmcnt(" #n ")" ::: "memory")
#define PG8_BAR __builtin_amdgcn_s_barrier()
#define PG8_SCHED __builtin_amdgcn_sched_barrier(0)
    Unit cur, nxt; int ui = 0;
    if (!S.next(0, cur)) return;
    f32x4 acc[2][2][4][2];
#pragma unroll
    for (int a = 0; a < 2; ++a)
#pragma unroll
        for (int b = 0; b < 2; ++b)
#pragma unroll
            for (int m = 0; m < 4; ++m)
#pragma unroll
                for (int n = 0; n < 2; ++n) acc[a][b][m][n] = (f32x4){0.f, 0.f, 0.f, 0.f};
    bf16x8 At[4][2], B0[2][2], B1[2][2];
    const char* cA = (const char*)g.A + (size_t)cur.pm * tstep; const char* cB = (const char*)g.Bt + (size_t)cur.pn * tstep;
    S.a_ready(cur);
    if constexpr (SP2) {
        PG8_STAGE(PG8_SB(0, 0), cB, voffB); PG8_STAGE(PG8_SB(0, 1), cB + hstep, voffB); PG8_STAGE(PG8_SA(0, 0), cA, voffA); PG8_STAGE(PG8_SA(0, 1), cA + hstep, voffA);
        if (wr == 1) PG8_BAR;
        PG8_WAIT_V(2); PG8_BAR;
        PG8_STAGE(PG8_SB(1, 0), cB + kstep, voffB); PG8_STAGE(PG8_SA(1, 0), cA + kstep, voffA); PG8_STAGE(PG8_SB(1, 1), cB + hstep + kstep, voffB);
        PG8_WAIT_V(6); PG8_BAR;
    } else {
        PG8_STAGE(PG8_SB(0, 0), cB, voffB); PG8_STAGE(PG8_SA(0, 0), cA, voffA); PG8_STAGE(PG8_SB(0, 1), cB + hstep, voffB); PG8_STAGE(PG8_SA(0, 1), cA + hstep, voffA);
        if (wr == 1) PG8_BAR;
        PG8_WAIT_V(4); PG8_BAR;
        PG8_STAGE(PG8_SB(1, 0), cB + kstep, voffB); PG8_STAGE(PG8_SA(1, 0), cA + kstep, voffA); PG8_STAGE(PG8_SB(1, 1), cB + hstep + kstep, voffB);
        PG8_WAIT_V(6); PG8_BAR;
    }
    for (;;) {
        const bool has_next = S.next(ui + 1, nxt);
        const char* nA = has_next ? (const char*)g.A + (size_t)nxt.pm * tstep : cA; const char* nB = has_next ? (const char*)g.Bt + (size_t)nxt.pn * tstep : cB;
        for (int t = 0; t < nt; t += 2) {
            if constexpr (Epi::HOOK) { if (t == 8 || t == 24) E.hook(acc, cur, wr, wc, fr, fq, t == 8 ? 0 : 1); }
            const bool last = (t == nt - 2);
            const char* a1 = cA + (size_t)(t + 1) * kstep;
            const char* a2 = last ? nA : cA + (size_t)(t + 2) * kstep; const char* b2 = last ? nB : cB + (size_t)(t + 2) * kstep;
            const char* a3 = a2 + kstep; const char* b3 = b2 + kstep;
            if (last && has_next) S.a_ready(nxt);
            if constexpr (SP2) {
            PG8_LDB(B0, 0, 0); PG8_LDB(B1, 0, 1); PG8_SCHED; PG8_LDA(At, 0, 0); PG8_STAGE(PG8_SA(1, 1), a1 + hstep, voffA);
            PG8_WAIT_V(8); PG8_WAIT_L(0); PG8_BAR; PG8_MMA(0, 0, At, B0); PG8_MMA(0, 1, At, B1); PG8_BAR; PG8_SCHED;
            PG8_LDA(At, 0, 1); PG8_STAGE(PG8_SB(0, 0), b2, voffB); PG8_STAGE(PG8_SB(0, 1), b2 + hstep, voffB); PG8_STAGE(PG8_SA(0, 0), a2, voffA);
            PG8_WAIT_V(8); PG8_WAIT_L(0); PG8_BAR; PG8_MMA(1, 0, At, B0); PG8_MMA(1, 1, At, B1); PG8_BAR; PG8_SCHED;
            PG8_LDB(B0, 1, 0); PG8_LDB(B1, 1, 1); PG8_SCHED; PG8_LDA(At, 1, 0); PG8_STAGE(PG8_SA(0, 1), a2 + hstep, voffA);
            PG8_WAIT_V(8); PG8_WAIT_L(0); PG8_BAR; PG8_MMA(0, 0, At, B0); PG8_MMA(0, 1, At, B1); PG8_BAR; PG8_SCHED;
            PG8_LDA(At, 1, 1); PG8_STAGE(PG8_SB(1, 0), b3, voffB); PG8_STAGE(PG8_SB(1, 1), b3 + hstep, voffB); PG8_STAGE(PG8_SA(1, 0), a3, voffA);
            PG8_WAIT_V(8); PG8_WAIT_L(0); PG8_BAR; PG8_MMA(1, 0, At, B0); PG8_MMA(1, 1, At, B1); PG8_BAR; PG8_SCHED;
            } else {
            PG8_LDB(B0, 0, 0); PG8_SCHED; PG8_LDA(At, 0, 0); PG8_STAGE(PG8_SA(1, 1), a1 + hstep, voffA);
            PG8_WAIT_L(8); PG8_BAR; PG8_WAIT_L(0); PG8_MMA(0, 0, At, B0); PG8_BAR; PG8_SCHED;
            PG8_LDB(B1, 0, 1); PG8_STAGE(PG8_SB(0, 0), b2, voffB);
            PG8_BAR; PG8_WAIT_L(0); PG8_MMA(0, 1, At, B1); PG8_BAR;
            PG8_LDA(At, 0, 1); PG8_STAGE(PG8_SA(0, 0), a2, voffA);
            PG8_BAR; PG8_WAIT_L(0); PG8_MMA(1, 0, At, B0); PG8_BAR; PG8_SCHED;
            PG8_STAGE(PG8_SB(0, 1), b2 + hstep, voffB);
            PG8_WAIT_V(6); PG8_BAR; PG8_MMA(1, 1, At, B1); PG8_BAR;
            PG8_LDB(B0, 1, 0); PG8_SCHED; PG8_LDA(At, 1, 0); PG8_STAGE(PG8_SA(0, 1), a2 + hstep, voffA);
            PG8_WAIT_L(8); PG8_BAR; PG8_WAIT_L(0); PG8_MMA(0, 0, At, B0); PG8_BAR; PG8_SCHED;
            PG8_LDB(B1, 1, 1); PG8_STAGE(PG8_SB(1, 0), b3, voffB);
            PG8_BAR; PG8_WAIT_L(0); PG8_MMA(0, 1, At, B1); PG8_BAR;
            PG8_LDA(At, 1, 1); PG8_STAGE(PG8_SA(1, 0), a3, voffA);
            PG8_BAR; PG8_WAIT_L(0); PG8_MMA(1, 0, At, B0); PG8_BAR; PG8_SCHED;
            PG8_STAGE(PG8_SB(1, 1), b3 + hstep, voffB);
            PG8_WAIT_V(6); PG8_BAR; PG8_MMA(1, 1, At, B1); PG8_BAR;
            }
        }
        if constexpr (ALIGN_EPI) { if (wr == 0) PG8_BAR; }
        if constexpr (!Epi::AFTER_DRAIN) { E(acc, cur, wr, wc, fr, fq); S.done(cur); }
        if (!has_next) break;
#pragma unroll
        for (int a = 0; a < 2; ++a)
#pragma unroll
            for (int b = 0; b < 2; ++b)
#pragma unroll
                for (int m = 0; m < 4; ++m)
#pragma unroll
                    for (int n = 0; n < 2; ++n) acc[a][b][m][n] = (f32x4){0.f, 0.f, 0.f, 0.f};
        cur = nxt; cA = nA; cB = nB; ++ui;
        if constexpr (ALIGN_EPI) { if (wr == 1) PG8_BAR; }
    }
    PG8_WAIT_V(0);
    if constexpr (!ALIGN_EPI) { if (wr == 0) PG8_BAR; }
    PG8_BAR;
    if constexpr (Epi::AFTER_DRAIN) { E.fused(acc, cur, wr, wc, fr, fq, lds, wid, lane); S.done(cur); }
#undef PG8_SA
#undef PG8_SB
#undef PG8_STAGE
#undef PG8_LDA
#undef PG8_LDB
#undef PG8_MMA
#undef PG8_WAIT_V
#undef PG8_WAIT_L
#undef PG8_BAR
#undef PG8_SCHED
}
}
namespace pg8 { typedef PG8_LAS unsigned char* PG8_LAS_T; }
constexpr int LDP_ATT = 12032;
namespace att {
constexpr int D = 128, LDP = LDP_ATT; constexpr float SCALE = 0.08838834764831845f; constexpr float THR = 8.f;
constexpr int NW = 8, QBLK = 32, KVBLK = 64, QB = NW * QBLK; constexpr int SHM_V = KVBLK * D * 2, SHM_K = KVBLK * D * 2; constexpr int LDS_ATT = 2 * SHM_V + 2 * SHM_K + NW * 64 * 4;
using bf16 = __hip_bfloat16;
typedef short bf16x8 __attribute__((ext_vector_type(8)));
typedef short s16x4 __attribute__((ext_vector_type(4)));
typedef float f32x16 __attribute__((ext_vector_type(16)));
typedef float f32x4 __attribute__((ext_vector_type(4)));
typedef unsigned u32x4 __attribute__((ext_vector_type(4)));
template <class A, class Bt> struct same_t { static constexpr bool v = false; };
template <class A> struct same_t<A, A> { static constexpr bool v = true; };

#define KSWZ(row, colB) ((row) * 256 + ((colB) ^ (((row) & 7) << 4)))
#define SBAR() __builtin_amdgcn_sched_barrier(0)
__device__ __forceinline__ int v_st(int k, int c) { const int kk = (k & ~0xC) | ((k & 4) << 1) | ((k & 8) >> 1); return ((kk >> 3) * 4 + (c >> 5)) * 512 + ((kk & 7) * 32 + (c & 31)) * 2; }
__device__ __forceinline__ int v_rd_base(int lane) { return ((lane & 3) << 3) | (((lane >> 2) & 3) << 6) | (((lane >> 4) & 1) << 5) | (((lane >> 5) & 1) << 8); }
constexpr int v_rd_off(int d0, int ks, int half) { return d0 * 512 + ks * 4096 + half * 2048; }
__device__ __forceinline__ int crow(int r, int hi) { return (r & 3) + 8 * (r >> 2) + 4 * hi; }
__device__ __forceinline__ unsigned cvtpk(float lo, float hi) {
    unsigned r; asm volatile("v_cvt_pk_bf16_f32 %0, %1, %2" : "=v"(r) : "v"(lo), "v"(hi)); return r;
}
__device__ __forceinline__ bf16x8 pack8(f32x4 a, f32x4 b) {
    u32x4 w = {cvtpk(a[0], a[1]), cvtpk(a[2], a[3]), cvtpk(b[0], b[1]), cvtpk(b[2], b[3])};
    return *reinterpret_cast<bf16x8*>(&w);
}
template <class T> __device__ __forceinline__ bf16x8 load8(const T* p) {
    if constexpr (same_t<T, float>::v) { return pack8(*(const f32x4*)p, *(const f32x4*)(p + 4)); }
    else { return *reinterpret_cast<const bf16x8*>(p); }
}
__device__ __forceinline__ void mask_tile(f32x16& p0, f32x16& p1, int dq, unsigned W) {
    const float NEG = -__builtin_inff();
#pragma unroll
    for (int r = 0; r < 16; ++r) {
        const int c = (r & 3) + 8 * (r >> 2);
        if ((unsigned)(dq - c) >= W) p0[r] = NEG;
        if ((unsigned)(dq - c - 32) >= W) p1[r] = NEG;
    }
}
__device__ __forceinline__ void partialSM(f32x16& p0, f32x16& p1, float& m_reg, float& mn, float& alpha) {
    float pmax = p0[0]; for (int r = 1; r < 16; ++r) pmax = fmaxf(pmax, p0[r]); for (int r = 0; r < 16; ++r) pmax = fmaxf(pmax, p1[r]);
    { auto rr = __builtin_amdgcn_permlane32_swap(__float_as_uint(pmax), __float_as_uint(pmax), false, false);
      pmax = fmaxf(__uint_as_float(rr[0]), __uint_as_float(rr[1])); }
    constexpr float C2 = 1.4426950408889634f * SCALE;
    if (__builtin_expect(__all((pmax - m_reg) * SCALE <= THR), 1)) { mn = m_reg; alpha = 1.f; }
    else { mn = fmaxf(m_reg, pmax); alpha = __builtin_amdgcn_exp2f((m_reg - mn) * C2); m_reg = mn; }
    const float mnL = -mn * C2;
    for (int r = 0; r < 16; ++r) p0[r] = fmaf(p0[r], C2, mnL); for (int r = 0; r < 16; ++r) p1[r] = fmaf(p1[r], C2, mnL);
    for (int r = 0; r < 16; ++r) p0[r] = __builtin_amdgcn_exp2f(p0[r]);
}
__device__ __forceinline__ void finishSM(f32x16& p0, f32x16& p1, float alpha, float& l_reg, bf16x8& pa0, bf16x8& pa1, bf16x8& pa2, bf16x8& pa3) {
    for (int r = 0; r < 16; ++r) p1[r] = __builtin_amdgcn_exp2f(p1[r]);
    float ps = 0; for (int r = 0; r < 16; ++r) ps += p0[r]; for (int r = 0; r < 16; ++r) ps += p1[r];
    { auto rr = __builtin_amdgcn_permlane32_swap(__float_as_uint(ps), __float_as_uint(ps), false, false);
      ps = __uint_as_float(rr[0]) + __uint_as_float(rr[1]); }
    l_reg = l_reg * alpha + ps;
#define PK4(P, B_, OUT) do { unsigned a0 = cvtpk(P[B_+0], P[B_+1]), a1 = cvtpk(P[B_+2], P[B_+3]);                          \
        unsigned b0 = cvtpk(P[B_+4], P[B_+5]), b1 = cvtpk(P[B_+6], P[B_+7]);                                             \
        auto r0 = __builtin_amdgcn_permlane32_swap(a0, b0, false, false); auto r1 = __builtin_amdgcn_permlane32_swap(a1, b1, false, false); \
        u32x4 w = {r0[0], r1[0], r0[1], r1[1]}; OUT = *reinterpret_cast<bf16x8*>(&w); } while (0)
    PK4(p0, 0, pa0); PK4(p0, 8, pa1); PK4(p1, 0, pa2); PK4(p1, 8, pa3);
#undef PK4
}
enum { M_DA = 0, M_FOX = 1, M_SEL = 2, M_WIN = 3 };
template <int KB, int MODE>
__device__ __forceinline__ void qkt(f32x16& p0, f32x16& p1, const char* K_lds, int r32, int hi, const bf16x8* qr) {
    p0 = f32x16{}; p1 = f32x16{};
    const char* kb[4];
#pragma unroll
    for (int dd = 0; dd < 4; ++dd) kb[dd] = K_lds + KB * SHM_K + KSWZ(r32, (dd * 16 + hi * 8) * 2);
    constexpr int ND = (MODE == M_DA) ? 4 : 8;
#pragma unroll
    for (int d0 = 0; d0 < ND; ++d0) { const char* a = kb[d0 & 3] + (d0 >> 2) * 128;
        bf16x8 b0 = *reinterpret_cast<const bf16x8*>(a);
        bf16x8 b1 = *reinterpret_cast<const bf16x8*>(a + 32 * 256);
        p0 = __builtin_amdgcn_mfma_f32_32x32x16_bf16(b0, qr[d0], p0, 0, 0, 0);
        p1 = __builtin_amdgcn_mfma_f32_32x32x16_bf16(b1, qr[d0], p1, 0, 0, 0); }
}
template <int VB, bool SK>
__device__ __forceinline__ void pv_tile(f32x16* o, int vb0, bf16x8 pa0, bf16x8 pa1, bf16x8 pa2, bf16x8 pa3, bool act) {
    if (SK && !act) return;
#define TRRD(dst, off) asm volatile("ds_read_b64_tr_b16 %0, %1 offset:%2" : "=&v"(dst) : "v"(vb0), "i"(off) : "memory")
#define PV_D0(d0) do { s16x4 l0, l1, l2, l3, h0, h1, h2, h3; constexpr int b_ = VB * SHM_V + v_rd_off(d0, 0, 0);     \
        TRRD(l0, b_); TRRD(h0, b_ + 2048); TRRD(l1, b_ + 4096); TRRD(h1, b_ + 6144); TRRD(l2, b_ + 8192); TRRD(h2, b_ + 10240); TRRD(l3, b_ + 12288); TRRD(h3, b_ + 14336); \
        asm volatile("s_waitcnt lgkmcnt(0)" ::: "memory"); SBAR();                 \
        o[d0] = __builtin_amdgcn_mfma_f32_32x32x16_bf16(pa0, (bf16x8){l0[0], l0[1], l0[2], l0[3], h0[0], h0[1], h0[2], h0[3]}, o[d0], 0, 0, 0);   \
        o[d0] = __builtin_amdgcn_mfma_f32_32x32x16_bf16(pa1, (bf16x8){l1[0], l1[1], l1[2], l1[3], h1[0], h1[1], h1[2], h1[3]}, o[d0], 0, 0, 0);   \
        o[d0] = __builtin_amdgcn_mfma_f32_32x32x16_bf16(pa2, (bf16x8){l2[0], l2[1], l2[2], l2[3], h2[0], h2[1], h2[2], h2[3]}, o[d0], 0, 0, 0);   \
        o[d0] = __builtin_amdgcn_mfma_f32_32x32x16_bf16(pa3, (bf16x8){l3[0], l3[1], l3[2], l3[3], h3[0], h3[1], h3[2], h3[3]}, o[d0], 0, 0, 0); } while (0)
    PV_D0(0); PV_D0(1); PV_D0(2); PV_D0(3);
#undef PV_D0
#undef TRRD
}

struct BlockRef { const bf16* Q; const bf16* K; const bf16* V; bf16* O; int P0; int ldo; const float* cks; const unsigned* sel; };
struct Seam { bf16x8 qr[8]; bf16x8 st_v0, st_v1, st_k0, st_k1; };
__device__ __forceinline__ int swa_jlo(int P0, int W) { const int lowk = P0 - W + 1; return lowk > 0 ? lowk / KVBLK : 0; }
#define ROW(p, k0, rr) ((p) + (size_t)((k0) + (rr)) * LDP + sc)
#define VMW() asm volatile("s_waitcnt vmcnt(0)" ::: "memory")
#define VMWN(n) asm volatile("s_waitcnt vmcnt(%0)" :: "i"(n) : "memory")
#define SLOAD_H(Kp, Vp, k0) do { S.st_v0 = load8<bf16>(ROW(Vp, k0, sr)); S.st_v1 = load8<bf16>(ROW(Vp, k0, 32 + sr));              \
                         S.st_k0 = load8<bf16>(ROW(Kp, k0, sr)); S.st_k1 = load8<bf16>(ROW(Kp, k0, 32 + sr)); } while (0)
#define SWRITE_HK(bf) do { *(bf16x8*)(K_lds + (bf) * SHM_K + kws) = S.st_k0; *(bf16x8*)(K_lds + (bf) * SHM_K + kws + 32 * 256) = S.st_k1; } while (0)
#define SWRITE_HV(bf) do { *(bf16x8*)(V_lds + (bf) * SHM_V + vst0) = S.st_v0; *(bf16x8*)(V_lds + (bf) * SHM_V + vst1) = S.st_v1; } while (0)
#define SWRITE_H(bf) do { SWRITE_HV(bf); SWRITE_HK(bf); } while (0)
template <int MODE>
__device__ __forceinline__ void att_prime(const BlockRef& cur, int W, char* lds, Seam& S, int tid_in) {
    constexpr int ND = (MODE == M_DA) ? 4 : 8;
    const int tid = tid_in, wid = __builtin_amdgcn_readfirstlane(tid >> 6), lane = tid & 63, r32 = lane & 31, hi = lane >> 5;
    const int sr = tid >> 4, sc = (tid & 15) * 8, kws = KSWZ(sr, sc * 2); char* K_lds = lds + 2 * SHM_V;
    const int kb0 = swa_jlo(cur.P0, W) * KVBLK;
#pragma unroll
    for (int d0 = 0; d0 < ND; ++d0) S.qr[d0] = load8<bf16>(cur.Q + (size_t)(wid * QBLK + r32) * LDP + d0 * 16 + hi * 8);
    SLOAD_H(cur.K, cur.V, kb0); VMW(); SWRITE_HK(0);
    __syncthreads();
}
template <int MODE>
__device__ __forceinline__ void att_block(const BlockRef& cur, const BlockRef& nxt, int skv, int W, char* lds, Seam& S, int tid_in) {
    constexpr int ND = (MODE == M_DA) ? 4 : 8;
    const int tid = tid_in, wid = __builtin_amdgcn_readfirstlane(tid >> 6), lane = tid & 63, r32 = lane & 31, hi = lane >> 5;
    const int j_lo = swa_jlo(cur.P0, W);
    int j_hi = (cur.P0 + QB - 1) / KVBLK + 1; if (j_hi > skv / KVBLK) j_hi = skv / KVBLK;
    const int NT = j_hi - j_lo;
    const int kbn = swa_jlo(nxt.P0, W) * KVBLK;
    const int qlo = cur.P0 + wid * QBLK, qm = qlo + r32 - 4 * hi;
    char* V_lds = lds; char* K_lds = lds + 2 * SHM_V;
    float* ws = (float*)(lds + 2 * SHM_V + 2 * SHM_K) + wid * 64; float* li_l = ws, * al_l = ws + 32;
    float* ck_l = (float*)(lds + LDS_ATT);
    float m_reg = -1e30f, l_reg = 0; f32x16 o[4] = {};
    const int sr = tid >> 4, sc = (tid & 15) * 8, vst0 = v_st(sr, sc), vst1 = v_st(32 + sr, sc), kws = KSWZ(sr, sc * 2);
    const int vb0 = (int)(uintptr_t)V_lds + v_rd_base(lane);
    const bf16* Kh = cur.K; const bf16* Vh = cur.V;
    unsigned selw = 0xffffffffu;
    if constexpr (MODE == M_SEL) selw = cur.sel[qlo + r32];
    if constexpr (MODE == M_FOX) {
        for (int i = tid; i < cur.P0 + QB; i += 64 * NW) ck_l[i] = cur.cks[i];
        __syncthreads(); }
#define RESC(a) do { if (__any((a) < 1.f)) { if (hi == 0) al_l[r32] = (a); asm volatile("s_waitcnt lgkmcnt(0)" ::: "memory");              \
                     for (int d_ = 0; d_ < 4; ++d_) for (int r = 0; r < 16; ++r) o[d_][r] *= al_l[crow(r, hi)]; } } while (0)
#define KBASE(t) ((j_lo + (t)) * KVBLK)
#define MASKT(P0_, P1_, t) do { const int kb_ = KBASE(t); \
        if constexpr (MODE == M_FOX) { const float* c_ = ck_l + kb_ + 4 * hi; const float cq_ = ck_l[qm + 4 * hi]; \
            _Pragma("unroll") for (int i_ = 0; i_ < 4; ++i_) { const f32x4 a_ = *(const f32x4*)(c_ + 8 * i_), b_ = *(const f32x4*)(c_ + 32 + 8 * i_); \
                _Pragma("unroll") for (int j_ = 0; j_ < 4; ++j_) { P0_[4 * i_ + j_] += cq_ - a_[j_]; P1_[4 * i_ + j_] += cq_ - b_[j_]; } } } \
        if (kb_ + KVBLK - 1 > qlo || kb_ <= qlo + QBLK - 1 - W) mask_tile(P0_, P1_, qm - kb_, (unsigned)W); \
        if constexpr (MODE == M_SEL) { if (!((selw >> (j_lo + (t))) & 1u)) { const float NEG_ = -__builtin_inff(); \
            _Pragma("unroll") for (int r = 0; r < 16; ++r) { P0_[r] = NEG_; P1_[r] = NEG_; } } } } while (0)
#define SEAM_K0() do { VMWN(ND); SWRITE_HK(0); SBAR(); } while (0)
    f32x16 pA0, pA1, pB0, pB1; float mnA, mnB, alA, alB; bf16x8 pa0, pa1, pa2, pa3;
    SWRITE_HV(0); SBAR();
    if (NT > 1) { SLOAD_H(Kh, Vh, KBASE(1)); }
    SBAR(); qkt<0, MODE>(pA0, pA1, K_lds, r32, hi, S.qr);
    MASKT(pA0, pA1, 0); partialSM(pA0, pA1, m_reg, mnA, alA);
    if (NT > 1) { VMW(); SWRITE_H(1); }
    __syncthreads();
#define HALF_STEP(PX0, PX1, mnX, alX, PY0, PY1, alY, t, KB, VB, SB) do {                                                      \
        SBAR(); qkt<KB, MODE>(PX0, PX1, K_lds, r32, hi, S.qr);                                             \
        finishSM(PY0, PY1, alY, l_reg, pa0, pa1, pa2, pa3); SBAR();                                                           \
        if ((t) + 1 < NT) { SLOAD_H(Kh, Vh, KBASE((t) + 1)); SBAR(); }                                               \
        pv_tile<VB, false>(o, vb0, pa0, pa1, pa2, pa3, true); MASKT(PX0, PX1, (t)); partialSM(PX0, PX1, m_reg, mnX, alX);                                        \
        __syncthreads();                                                                                                      \
        if ((t) + 1 < NT) { VMW(); SWRITE_H(SB); }                                                                          \
        RESC(alX); __syncthreads(); } while (0)
    for (int t = 1; t + 1 < NT; t += 2) {
        HALF_STEP(pB0, pB1, mnB, alB, pA0, pA1, alA, t, 1, 0, 0);
        HALF_STEP(pA0, pA1, mnA, alA, pB0, pB1, alB, t + 1, 0, 1, 1);
    }
    const bool even = (NT & 1) == 0;
    if (even) { SBAR(); qkt<1, MODE>(pB0, pB1, K_lds, r32, hi, S.qr); SBAR(); }
    SLOAD_H(nxt.K, nxt.V, kbn); SBAR();
#pragma unroll
    for (int d0 = 0; d0 < ND; ++d0) S.qr[d0] = load8<bf16>(nxt.Q + (size_t)(wid * QBLK + r32) * LDP + d0 * 16 + hi * 8);
    SBAR();
    finishSM(pA0, pA1, alA, l_reg, pa0, pa1, pa2, pa3); SBAR();
    pv_tile<0, false>(o, vb0, pa0, pa1, pa2, pa3, true);
    if (even) { MASKT(pB0, pB1, NT - 1); partialSM(pB0, pB1, m_reg, mnB, alB); __syncthreads(); RESC(alB);
        finishSM(pB0, pB1, alB, l_reg, pa0, pa1, pa2, pa3); SBAR(); pv_tile<1, false>(o, vb0, pa0, pa1, pa2, pa3, true); }
    SBAR(); SEAM_K0();
    if (hi == 0) li_l[r32] = l_reg; asm volatile("s_waitcnt lgkmcnt(0)" ::: "memory");
    float rli[16];
#pragma unroll
    for (int r = 0; r < 16; ++r) rli[r] = __builtin_amdgcn_rcpf(li_l[crow(r, hi)]);
    const int ldo = cur.ldo;
    bf16* Ow = cur.O + (size_t)(wid * QBLK) * ldo;
#pragma unroll
    for (int r = 0; r < 16; ++r) { const int orow = crow(r, hi);
#pragma unroll
        for (int d0 = 0; d0 < 4; ++d0) { const float v = o[d0][r] * rli[r];
            const float vn = __int_as_float(__builtin_amdgcn_mov_dpp(__float_as_int(v), 0xB1, 0xF, 0xF, true));
            if ((r32 & 1) == 0) *(unsigned*)(Ow + (size_t)orow * ldo + d0 * 32 + r32) = cvtpk(v, vn); } }
    __syncthreads();
#undef RESC
#undef KBASE
#undef MASKT
#undef SEAM_K0
#undef HALF_STEP
}
#undef ROW
#undef VMW
#undef VMWN
#undef SLOAD_H
#undef SWRITE_HK
#undef SWRITE_HV
#undef SWRITE_H
#undef KSWZ
#undef SBAR
}
constexpr int NBATCH = 4, SEQ = 2048, T = NBATCH * SEQ, DM = 2048, FF = 5632, DEPTH = 2;
constexpr int LDP = 12032;
constexpr int PC_AQ = 0, PC_AK = 512, PC_AV = 1024, PC_BQ = 1536, PC_BKV = 2560, PC_CQ = 4096, PC_CK = 4608, PC_CV = 5120, PC_GM = 5632, PC_BG = 11776, PC_CF = 11800;
constexpr float EPS = 1e-6f;
constexpr int NWAVES = 8, NTHR = 512;
typedef unsigned short bf16r;
typedef float f32x2 __attribute__((ext_vector_type(2)));
typedef float f32x4 __attribute__((ext_vector_type(4)));
typedef float f32x16 __attribute__((ext_vector_type(16)));
typedef short bf16x8 __attribute__((ext_vector_type(8)));
typedef unsigned u32x4 __attribute__((ext_vector_type(4)));
typedef unsigned u32x2 __attribute__((ext_vector_type(2)));
constexpr size_t MiB = 1u << 20;
constexpr size_t WS_CTL = 0;
constexpr size_t WS_WGU1 = 1 * MiB, WS_WD1 = WS_WGU1 + 44 * MiB, WS_WGU2 = WS_WD1 + 22 * MiB, WS_WD2 = WS_WGU2 + 44 * MiB, WS_WIN = WS_WD2 + 22 * MiB;
constexpr size_t WS_WA = WS_WIN + 47 * MiB, WS_WB = WS_WA + 2 * MiB, WS_WC = WS_WB + 4 * MiB, WS_WO = WS_WC + 2 * MiB, WS_W1T = WS_WO + 8 * MiB;
constexpr size_t WS_H = WS_W1T + 4 * MiB;
constexpr size_t WS_P = WS_H + 32 * MiB;
constexpr size_t WS_YACC = WS_P + 188 * MiB;
constexpr size_t WS_YBF = WS_YACC + 64 * MiB;
constexpr size_t WS_OA = WS_YBF + 32 * MiB, WS_OB = WS_OA + 8 * MiB, WS_OC = WS_OB + 16 * MiB;
constexpr size_t WS_RDA = WS_OC + 8 * MiB, WS_RSEL = WS_RDA + 16 * MiB, WS_RWIN = WS_RSEL + 16 * MiB, WS_OCMP = WS_RWIN + 16 * MiB;
constexpr size_t WS_CPART = WS_OCMP + 16 * MiB;
constexpr size_t WS_SMALL = WS_CPART + 8 * MiB;
constexpr size_t WS_LOGF = WS_SMALL, WS_CUMS = WS_LOGF + 128 * 1024, WS_SELM = WS_CUMS + 128 * 1024, WS_KC = WS_SELM + 64 * 1024, WS_VC = WS_KC + 128 * 1024;
constexpr size_t WS_RS = WS_SMALL + 1 * MiB;
constexpr size_t WS_END = WS_RS + 7 * MiB;
constexpr int LDS_BYTES = 147456;
constexpr int LDS_SLOT = 140000;

__device__ __forceinline__ float bf2f(unsigned short h) { return __uint_as_float(((unsigned)h) << 16); }
__device__ __forceinline__ unsigned pk2(float lo, float hi) { return pg8::cvt_pk_bf16(lo, hi); }
__device__ __forceinline__ float shx(float v, int msk, int lane) { return __int_as_float(__builtin_amdgcn_ds_bpermute((lane ^ msk) << 2, __float_as_int(v))); }
__device__ __forceinline__ float wsum(float v, int lane) {
#pragma unroll
    for (int o = 1; o < 64; o <<= 1) v += shx(v, o, lane);
    return v; }
__device__ __forceinline__ float hsum32(float v, int lane) {
#pragma unroll
    for (int o = 1; o < 32; o <<= 1) v += shx(v, o, lane);
    return v; }
#define LDSW() asm volatile("s_waitcnt lgkmcnt(0)" ::: "memory")

struct Params { const float* in[28]; float* out; unsigned char* ws; int ph_lo, ph_hi; };

__device__ __forceinline__ int win_src(int n) {
    if (n < 4096) return n; if (n < 5632) return n + 24; if (n < 11776) return n + 28; if (n < 11800) return 4096 + (n - 11776); if (n < 11804) return 5656 + (n - 11800); return -1; }
__device__ __forceinline__ void cvt_item(const float* W, int ldw, int K, bf16r* WT, int kind, int item, int nblk, float* scr, int lane, int ldk = 0, int koff = 0) {
    if (ldk == 0) ldk = K;
    const int kb = item / nblk, nb = item - kb * nblk, k0 = 64 * kb, n0 = 32 * nb;
    const int nl = n0 + (lane & 31);
    int sc = nl; if (kind == 3) sc = win_src(nl);
    const float* wp = W + (size_t)(k0 + (lane >> 5)) * ldw + (sc < 0 ? 0 : sc);
#pragma unroll 8
    for (int i = 0; i < 32; ++i) { const float v = wp[(size_t)(2 * i) * ldw]; scr[(2 * i + (lane >> 5)) * 33 + (lane & 31)] = sc < 0 ? 0.f : v; }
    LDSW();
    const int c = lane & 7;
#pragma unroll
    for (int j = 0; j < 4; ++j) { const int n = (lane >> 3) + 8 * j; const float* s = scr + (8 * c) * 33 + n; const int nlog = n0 + n;
        int drow = nlog; if (kind == 1 || kind == 2) drow = (nlog >> 7) * 256 + (nlog & 127) + (kind == 2 ? 128 : 0);
        u32x4 o; o.x = pk2(s[0 * 33], s[1 * 33]); o.y = pk2(s[2 * 33], s[3 * 33]); o.z = pk2(s[4 * 33], s[5 * 33]); o.w = pk2(s[6 * 33], s[7 * 33]);
        *(u32x4*)(WT + (size_t)drow * ldk + koff + k0 + 8 * c) = o; }
    LDSW();
}
__device__ __forceinline__ void phase_convert(const Params& p, int layer, char* lds, int gw, int NGW, int wave, int lane) {
    float* scr = (float*)(lds + wave * 8704);
    unsigned char* ws = p.ws;
    constexpr int I_G = 32 * 176, I_D = 88 * 64, I_WIN = 32 * 376, I_A = 8 * 64, I_B = 16 * 64, I_O = 32 * 64, I_W1 = 128 * 4;
    constexpr int NIT = 4 * I_G + 2 * I_D + I_WIN + 2 * I_A + I_B + I_O + 2 * I_W1;
    const size_t lF = (size_t)layer * DM * FF;
    for (int it = gw; it < NIT; it += NGW) {
        int r = it;
        if (r < I_G) { cvt_item(p.in[3] + lF, FF, DM, (bf16r*)(ws + WS_WGU1), 1, r, 176, scr, lane); continue; } r -= I_G;
        if (r < I_G) { cvt_item(p.in[4] + lF, FF, DM, (bf16r*)(ws + WS_WGU1), 2, r, 176, scr, lane); continue; } r -= I_G;
        if (r < I_D) { cvt_item(p.in[5] + lF, DM, FF, (bf16r*)(ws + WS_WD1), 0, r, 64, scr, lane); continue; } r -= I_D;
        if (r < I_G) { cvt_item(p.in[25] + lF, FF, DM, (bf16r*)(ws + WS_WGU2), 1, r, 176, scr, lane); continue; } r -= I_G;
        if (r < I_G) { cvt_item(p.in[26] + lF, FF, DM, (bf16r*)(ws + WS_WGU2), 2, r, 176, scr, lane); continue; } r -= I_G;
        if (r < I_D) { cvt_item(p.in[27] + lF, DM, FF, (bf16r*)(ws + WS_WD2), 0, r, 64, scr, lane); continue; } r -= I_D;
        if (r < I_WIN) { cvt_item(p.in[7] + (size_t)layer * DM * 11804, 11804, DM, (bf16r*)(ws + WS_WIN), 3, r, 376, scr, lane); continue; } r -= I_WIN;
        if (r < I_A) { cvt_item(p.in[20] + (size_t)layer * 512 * DM, DM, 512, (bf16r*)(ws + WS_WA), 0, r, 64, scr, lane, 2048, 0); continue; } r -= I_A;
        if (r < I_B) { cvt_item(p.in[21] + (size_t)layer * 1024 * DM, DM, 1024, (bf16r*)(ws + WS_WA), 0, r, 64, scr, lane, 2048, 512); continue; } r -= I_B;
        if (r < I_A) { cvt_item(p.in[22] + (size_t)layer * 512 * DM, DM, 512, (bf16r*)(ws + WS_WA), 0, r, 64, scr, lane, 2048, 1536); continue; } r -= I_A;
        if (r < I_O) { cvt_item(p.in[23] + (size_t)layer * DM * DM, DM, DM, (bf16r*)(ws + WS_WO), 0, r, 64, scr, lane); continue; } r -= I_O;
        if (r < I_W1) { cvt_item(p.in[15] + (size_t)(layer * 2 + 0) * 8192 * 128, 128, 8192, (bf16r*)(ws + WS_W1T), 0, r, 4, scr, lane); continue; } r -= I_W1;
        cvt_item(p.in[15] + (size_t)(layer * 2 + 1) * 8192 * 128, 128, 8192, (bf16r*)(ws + WS_W1T) + 128 * 8192, 0, r, 4, scr, lane);
    }
}
__device__ __forceinline__ void phase_rms(const float* X, const float* gain, bf16r* H, unsigned long long* rss, int gw, int NGW, int lane) {
    f32x4 g[8];
#pragma unroll
    for (int j = 0; j < 8; ++j) g[j] = ((const f32x4*)gain)[64 * j + lane];
    for (int m = gw; m < T; m += NGW) {
        const f32x4* xr = (const f32x4*)(X + (size_t)m * DM) + lane;
        f32x4 v[8]; float s = 0.f;
#pragma unroll
        for (int j = 0; j < 8; ++j) { v[j] = xr[64 * j]; s += (v[j].x * v[j].x + v[j].y * v[j].y) + (v[j].z * v[j].z + v[j].w * v[j].w); }
        s = wsum(s, lane); if (lane == 0) rss[m] = (unsigned long long)((double)s * 65536.0 + 0.5);
        u32x2* o = (u32x2*)(H + (size_t)m * DM) + lane;
#pragma unroll
        for (int j = 0; j < 8; ++j) { u32x2 w; w.x = pk2(v[j].x * g[j].x, v[j].y * g[j].y); w.y = pk2(v[j].z * g[j].z, v[j].w * g[j].w); o[64 * j] = w; }
    }
}
template <int KIND>
__device__ __forceinline__ unsigned prep_chunk(const unsigned w, const float* gain, float scale, int lane, float c0, float s0, float c1, float s1) {
    float x0 = __uint_as_float(w << 16), x1 = __uint_as_float(w & 0xffff0000u);
    if (KIND == 0 || KIND == 2) { const float r = rsqrtf(wsum(x0 * x0 + x1 * x1, lane) * (1.f / 128.f) + EPS); x0 = x0 * r * gain[2 * lane]; x1 = x1 * r * gain[2 * lane + 1]; }
    if (KIND == 3) { const float r = rsqrtf(hsum32(x0 * x0 + x1 * x1, lane) * (1.f / 64.f) + EPS); x0 = x0 * r * gain[(2 * lane) & 63] * scale; x1 = x1 * r * gain[(2 * lane + 1) & 63] * scale; }
    if (KIND == 0 || KIND == 1) { const float y0 = shx(x0, 8, lane), y1 = shx(x1, 8, lane);
        if (lane < 8) { x0 = x0 * c0 - y0 * s0; x1 = x1 * c1 - y1 * s1; } else if (lane < 16) { x0 = x0 * c0 + y0 * s0; x1 = x1 * c1 + y1 * s1; } }
    if (KIND == 3) { const float y0 = shx(x0, 4, lane), y1 = shx(x1, 4, lane); const int l2 = lane & 31;
        if (l2 < 4) { x0 = x0 * c0 - y0 * s0; x1 = x1 * c1 - y1 * s1; } else if (l2 < 8) { x0 = x0 * c0 + y0 * s0; x1 = x1 * c1 + y1 * s1; } }
    return pk2(x0, x1);
}
__device__ __forceinline__ void rope_cs(float pos, float inv, float& c, float& s) {
    const float a = pos * inv; const double rev = (double)a * 0.15915494309189535; const float fr = (float)(rev - __builtin_rint(rev));
    c = __builtin_amdgcn_cosf(fr); s = __builtin_amdgcn_sinf(fr); }
__device__ __forceinline__ void phase_prep(const Params& p, int layer, int gw, int NGW, int lane) {
    bf16r* P = (bf16r*)(p.ws + WS_P); float* LOGF = (float*)(p.ws + WS_LOGF);
    const float* gaq = p.in[8] + layer * 64; const float* gak = p.in[9] + layer * 64; const float* gbq = p.in[12] + layer * 128; const float* gbk = p.in[13] + layer * 384;
    const float* gcq = p.in[17] + layer * 128; const float* gck = p.in[18] + layer * 128; const float* fb = p.in[19] + layer * 4;
    const int* positions = (const int*)p.in[1];
    const int fbi = 2 * (lane & 7), fai = 2 * (lane & 3);
    const float L2T = 18.931568569324174f; const float ib0 = __builtin_amdgcn_exp2f(-(float)fbi * (L2T / 16.f)), ib1 = __builtin_amdgcn_exp2f(-(float)(fbi + 1) * (L2T / 16.f));
    const float ia0 = __builtin_amdgcn_exp2f(-(float)fai * (L2T / 8.f)), ia1 = __builtin_amdgcn_exp2f(-(float)(fai + 1) * (L2T / 8.f));
    for (int tok = gw; tok < T; tok += NGW) {
        const float pos = (float)positions[tok];
        float cb0, sb0, cb1, sb1, ca0, sa0, ca1, sa1;
        rope_cs(pos, ib0, cb0, sb0); rope_cs(pos, ib1, cb1, sb1); rope_cs(pos, ia0, ca0, sa0); rope_cs(pos, ia1, ca1, sa1);
        bf16r* row = P + (size_t)tok * LDP;
        unsigned* rw = (unsigned*)row + lane;
        unsigned wq[8], wb[8], wk[6], wc[8];
#pragma unroll
        for (int i = 0; i < 8; ++i) wq[i] = rw[(PC_AQ + i * 128) / 2];
#pragma unroll
        for (int i = 0; i < 8; ++i) wb[i] = rw[(PC_BQ + i * 128) / 2];
#pragma unroll
        for (int i = 0; i < 6; ++i) wk[i] = rw[(PC_BKV + (i >> 1) * 512 + (i & 1) * 128) / 2];
#pragma unroll
        for (int i = 0; i < 8; ++i) wc[i] = rw[(PC_CQ + i * 128) / 2];
        const float cfv = (lane < 4) ? bf2f(row[PC_CF + lane]) : 0.f;
#pragma unroll
        for (int i = 0; i < 4; ++i) wq[i] = prep_chunk<3>(wq[i], gaq, 1.41421356237f, lane, ca0, sa0, ca1, sa1);
#pragma unroll
        for (int i = 4; i < 8; ++i) wq[i] = prep_chunk<3>(wq[i], gak, 1.f, lane, ca0, sa0, ca1, sa1);
#pragma unroll
        for (int i = 0; i < 8; ++i) wb[i] = prep_chunk<0>(wb[i], gbq, 1.f, lane, cb0, sb0, cb1, sb1);
#pragma unroll
        for (int i = 0; i < 2; ++i) { wk[i] = prep_chunk<1>(wk[i], gbq, 1.f, lane, cb0, sb0, cb1, sb1);
            wk[2 + i] = prep_chunk<0>(wk[2 + i], gbk + 128, 1.f, lane, cb0, sb0, cb1, sb1);
            wk[4 + i] = prep_chunk<0>(wk[4 + i], gbk + 256, 1.f, lane, cb0, sb0, cb1, sb1); }
#pragma unroll
        for (int i = 0; i < 4; ++i) { wc[i] = prep_chunk<2>(wc[i], gcq, 1.f, lane, 0, 0, 0, 0); wc[4 + i] = prep_chunk<2>(wc[4 + i], gck, 1.f, lane, 0, 0, 0, 0); }
#pragma unroll
        for (int i = 0; i < 8; ++i) rw[(PC_AQ + i * 128) / 2] = wq[i];
#pragma unroll
        for (int i = 0; i < 8; ++i) rw[(PC_BQ + i * 128) / 2] = wb[i];
#pragma unroll
        for (int i = 0; i < 6; ++i) rw[(PC_BKV + (i >> 1) * 512 + (i & 1) * 128) / 2] = wk[i];
#pragma unroll
        for (int i = 0; i < 8; ++i) rw[(PC_CQ + i * 128) / 2] = wc[i];
        if (lane < 4) { const float c = cfv + fb[lane]; const float lf = fminf(c, 0.f) - __logf(1.f + __expf(-fabsf(c)));
            const int b = tok / SEQ, s = tok - b * SEQ; LOGF[(size_t)(b * 4 + lane) * SEQ + s] = lf; }
    }
}
__device__ __forceinline__ void phase_cmp1(const Params& p, int layer, int gw, int NGW, int lane) {
    const bf16r* P = (const bf16r*)(p.ws + WS_P); const bf16r* W1T = (const bf16r*)(p.ws + WS_W1T); float* CPART = (float*)(p.ws + WS_CPART);
    const int hi = lane >> 5, l32 = lane & 31;
    for (int it = gw; it < 2048; it += NGW) {
        const int kind = it >> 10, rem = it & 1023, kc = rem & 31, nt = (rem >> 5) & 3, rt = rem >> 7;
        const int row = rt * 32 + l32, b = row >> 6, nb = (row >> 1) & 31, g = row & 1;
        const bf16r* arow = P + (size_t)(b * SEQ + nb * 64) * LDP + PC_BKV + (kind ? 256 : 0) + g * 128;
        const float* pos = p.in[14] + (size_t)(layer * 2 + kind) * 64 * 128;
        const bf16r* brow = W1T + (size_t)kind * 128 * 8192 + (size_t)(nt * 32 + l32) * 8192;
        f32x16 acc = {};
#pragma unroll 4
        for (int s = 0; s < 16; ++s) { const int k = kc * 256 + s * 16 + hi * 8, l = k >> 7, d = k & 127;
            const u32x4 aw = *(const u32x4*)(arow + (size_t)l * LDP + d); const f32x4 p0 = *(const f32x4*)(pos + l * 128 + d), p1 = *(const f32x4*)(pos + l * 128 + d + 4);
            u32x4 a2; a2.x = pk2(__uint_as_float(aw.x << 16) + p0.x, __uint_as_float(aw.x & 0xffff0000u) + p0.y); a2.y = pk2(__uint_as_float(aw.y << 16) + p0.z, __uint_as_float(aw.y & 0xffff0000u) + p0.w);
            a2.z = pk2(__uint_as_float(aw.z << 16) + p1.x, __uint_as_float(aw.z & 0xffff0000u) + p1.y); a2.w = pk2(__uint_as_float(aw.w << 16) + p1.z, __uint_as_float(aw.w & 0xffff0000u) + p1.w);
            const bf16x8 bv = *(const bf16x8*)(brow + k);
            acc = __builtin_amdgcn_mfma_f32_32x32x16_bf16(__builtin_bit_cast(bf16x8, a2), bv, acc, 0, 0, 0); }
        float* out = CPART + ((size_t)(kind * 32 + kc) * 256 + rt * 32) * 128 + nt * 32 + l32;
#pragma unroll
        for (int r = 0; r < 16; ++r) out[(size_t)((r & 3) + 8 * (r >> 2) + 4 * hi) * 128] = acc[r];
    }
    if (gw < 16) {
        const float* lf = (const float*)(p.ws + WS_LOGF) + (size_t)gw * SEQ + lane * 32; float* cs = (float*)(p.ws + WS_CUMS) + (size_t)gw * SEQ + lane * 32;
        f32x4 v[8]; float run = 0.f;
#pragma unroll
        for (int j = 0; j < 8; ++j) { v[j] = ((const f32x4*)lf)[j]; v[j].x += run; v[j].y += v[j].x; v[j].z += v[j].y; v[j].w += v[j].z; run = v[j].w; }
        float incl = run;
#pragma unroll
        for (int o = 1; o < 64; o <<= 1) { const float t = __int_as_float(__builtin_amdgcn_ds_bpermute(((lane - o) & 63) << 2, __float_as_int(incl))); if (lane >= o) incl += t; }
        const float off = incl - run;
#pragma unroll
        for (int j = 0; j < 8; ++j) ((f32x4*)cs)[j] = (v[j] + off) * 11.313708498984761f;
    }
}
__device__ __forceinline__ void phase_cmp2(const Params& p, int layer, char* lds, int gw, int NGW, int wave, int lane) {
    const float* CPART = (const float*)(p.ws + WS_CPART); float* hb = (float*)(lds + wave * 512);
    for (int it = gw; it < 512; it += NGW) {
        const int kind = it >> 8, row = it & 255, b = row >> 6, nb = (row >> 1) & 31, g = row & 1;
        float s0 = 0.f, s1 = 0.f;
#pragma unroll
        for (int kc = 0; kc < 32; ++kc) { const f32x2 v = *(const f32x2*)(CPART + ((size_t)(kind * 32 + kc) * 256 + row) * 128 + 2 * lane); s0 += v.x; s1 += v.y; }
        const float a0 = 0.7978845608028654f * (s0 + 0.044715f * s0 * s0 * s0), a1 = 0.7978845608028654f * (s1 + 0.044715f * s1 * s1 * s1);
        const float t0 = 1.f - 2.f * __builtin_amdgcn_rcpf(1.f + __expf(2.f * a0)), t1 = 1.f - 2.f * __builtin_amdgcn_rcpf(1.f + __expf(2.f * a1));
        LDSW(); hb[2 * lane] = 0.5f * s0 * (1.f + t0); hb[2 * lane + 1] = 0.5f * s1 * (1.f + t1); LDSW();
        const float* w2 = p.in[16] + (size_t)(layer * 2 + kind) * 128 * 128;
        float o0 = 0.f, o1 = 0.f;
#pragma unroll 32
        for (int n = 0; n < 128; ++n) { const float hv = hb[n]; o0 += hv * w2[n * 128 + lane]; o1 += hv * w2[n * 128 + lane + 64]; }
        if (kind == 0) { const float* gn = p.in[13] + layer * 384; const float r = rsqrtf(wsum(o0 * o0 + o1 * o1, lane) * (1.f / 128.f) + EPS); o0 = o0 * r * gn[lane]; o1 = o1 * r * gn[lane + 64]; }
        float* dst = (float*)(p.ws + (kind ? WS_VC : WS_KC)) + ((size_t)(b * 2 + g) * 32 + nb) * 128;
        dst[lane] = o0; dst[lane + 64] = o1;
    }
}
__device__ __forceinline__ void phase_cmpattn(const Params& p, char* lds, int bid, int G, int tid, int wave, int lane) {
    const bf16r* P = (const bf16r*)(p.ws + WS_P); bf16r* OCMP = (bf16r*)(p.ws + WS_OCMP); unsigned* SELM = (unsigned*)(p.ws + WS_SELM);
    float* kcT = (float*)lds;
    float* vcs = (float*)(lds + 16384);
    float* qf = (float*)(lds + 32768 + wave * 2048);
    float* pw = (float*)(lds + 49152 + wave * 512);
    const int n = lane & 31, hp = lane >> 5;
    for (int item = bid; item < 256; item += G) {
        const int bg = item >> 5, blk = item & 31, b = bg >> 1, g = bg & 1;
        __syncthreads();
        const float* KC = (const float*)(p.ws + WS_KC) + (size_t)bg * 4096; const float* VC = (const float*)(p.ws + WS_VC) + (size_t)bg * 4096;
        for (int i = tid; i < 4096; i += NTHR) { kcT[(i & 127) * 32 + (i >> 7)] = KC[i]; vcs[i] = VC[i]; }
        __syncthreads();
        const int qh_ = lane >> 4, qd0_ = (lane & 15) * 8;
        const bf16r* qsrc_ = P + ((size_t)b * SEQ + blk * 64 + wave * 8) * LDP + PC_BQ + (g * 4 + qh_) * 128 + qd0_;
        u32x4 wnext = *(const u32x4*)qsrc_;
        for (int i = 0; i < 8; ++i) {
            const int t = blk * 64 + wave * 8 + i; const size_t tok = (size_t)b * SEQ + t;
            const u32x4 wcur = wnext; if (i + 1 < 8) wnext = *(const u32x4*)(qsrc_ + (size_t)(i + 1) * LDP);
            const int cur = t >> 6, nvalid = (t + 1) >> 6;
            { const int h = qh_, d0 = qd0_; const u32x4 w = wcur;
              f32x4 a, c; a.x = __uint_as_float(w.x << 16); a.y = __uint_as_float(w.x & 0xffff0000u); a.z = __uint_as_float(w.y << 16); a.w = __uint_as_float(w.y & 0xffff0000u);
              c.x = __uint_as_float(w.z << 16); c.y = __uint_as_float(w.z & 0xffff0000u); c.z = __uint_as_float(w.w << 16); c.w = __uint_as_float(w.w & 0xffff0000u);
              LDSW(); *(f32x4*)(qf + h * 128 + d0) = a; *(f32x4*)(qf + h * 128 + d0 + 4) = c; LDSW(); }
            float s0 = 0.f, s1 = 0.f;
            const float* q0 = qf + (2 * hp) * 128; const float* q1 = q0 + 128;
#pragma unroll 4
            for (int d = 0; d < 128; d += 4) { const f32x4 a = *(const f32x4*)(q0 + d), c = *(const f32x4*)(q1 + d);
                const float k0 = kcT[d * 32 + n], k1 = kcT[(d + 1) * 32 + n], k2 = kcT[(d + 2) * 32 + n], k3 = kcT[(d + 3) * 32 + n];
                s0 += a.x * k0 + a.y * k1 + a.z * k2 + a.w * k3; s1 += c.x * k0 + c.y * k1 + c.z * k2 + c.w * k3; }
            const bool valid = n < nvalid; const float NEG = -1e30f;
            s0 = valid ? s0 * 0.08838834764831845f : NEG; s1 = valid ? s1 * 0.08838834764831845f : NEG;
            float m0 = s0, m1 = s1;
#pragma unroll
            for (int o = 1; o < 32; o <<= 1) { m0 = fmaxf(m0, shx(m0, o, lane)); m1 = fmaxf(m1, shx(m1, o, lane)); }
            float e0 = valid ? __expf(s0 - m0) : 0.f, e1 = valid ? __expf(s1 - m1) : 0.f;
            const float z0 = hsum32(e0, lane), z1 = hsum32(e1, lane);
            const float p0 = nvalid > 0 ? e0 / z0 : 0.f, p1 = nvalid > 0 ? e1 / z1 : 0.f;
            float imp = p0 + p1; imp += shx(imp, 32, lane);
            *(f32x2*)(pw + n * 4 + 2 * hp) = (f32x2){p0, p1};
            const bool forced = (n == 0) || (n == cur) || (n == cur - 1);
            const float score = forced ? 1e4f : (n <= cur ? imp : -1.f);
            int rank = 0;
#pragma unroll
            for (int m = 0; m < 32; ++m) { const float sm = __int_as_float(__builtin_amdgcn_readlane(__float_as_int(score), m)); rank += (sm > score || (sm == score && m < n)) ? 1 : 0; }
            const unsigned long long bal = __builtin_amdgcn_ballot_w64(rank < 8);
            if (lane == 0) SELM[(size_t)bg * SEQ + t] = (unsigned)(bal & 0xffffffffull);
            LDSW();
            float o[4][2] = {};
            for (int m = 0; m < nvalid; ++m) { const f32x2 v = *(const f32x2*)(vcs + m * 128 + 2 * lane); const f32x4 ph = *(const f32x4*)(pw + m * 4);
                o[0][0] += ph.x * v.x; o[0][1] += ph.x * v.y; o[1][0] += ph.y * v.x; o[1][1] += ph.y * v.y; o[2][0] += ph.z * v.x; o[2][1] += ph.z * v.y; o[3][0] += ph.w * v.x; o[3][1] += ph.w * v.y; }
#pragma unroll
            for (int h = 0; h < 4; ++h) *((unsigned*)(OCMP + tok * 1024 + (g * 4 + h) * 128) + lane) = pk2(o[h][0], o[h][1]);
        }
    }
}
__device__ __forceinline__ void phase_combine(const Params& p, int layer, int gw, int NGW, int lane) {
    const bf16r* P = (const bf16r*)(p.ws + WS_P); const unsigned* RDA = (const unsigned*)(p.ws + WS_RDA); const unsigned* RSEL = (const unsigned*)(p.ws + WS_RSEL);
    const unsigned* RWIN = (const unsigned*)(p.ws + WS_RWIN); const unsigned* OCMP = (const unsigned*)(p.ws + WS_OCMP);
    unsigned* OA = (unsigned*)(p.ws + WS_OA);
    const float* lp = p.in[10] + layer * 256; const float* og = p.in[11] + layer * 128;
    const float lam_init = 0.8f - 0.6f * __expf(-0.3f * (float)layer);
    const float lam = __expf(wsum(lp[lane] * lp[64 + lane], lane)) - __expf(wsum(lp[128 + lane] * lp[192 + lane], lane)) + lam_init;
    const float g0 = og[2 * lane] * (1.f - lam_init), g1 = og[2 * lane + 1] * (1.f - lam_init);
    for (int tok = gw; tok < T; tok += NGW) {
        unsigned da[8], oc[8], rs[8], rw[8];
#pragma unroll
        for (int i = 0; i < 8; ++i) da[i] = RDA[(size_t)tok * 512 + i * 64 + lane];
#pragma unroll
        for (int i = 0; i < 8; ++i) { oc[i] = OCMP[(size_t)tok * 512 + i * 64 + lane]; rs[i] = RSEL[(size_t)tok * 512 + i * 64 + lane]; rw[i] = RWIN[(size_t)tok * 512 + i * 64 + lane]; }
        const float gl = pg8::sigmoidf_(bf2f((P + (size_t)tok * LDP + PC_BG)[lane < 24 ? lane : 0]));
        unsigned oa[4], ob[8];
#pragma unroll
        for (int h = 0; h < 4; ++h) { const unsigned a = da[2 * h], c = da[2 * h + 1];
            const float v0 = __uint_as_float(a << 16) - lam * __uint_as_float(c << 16), v1 = __uint_as_float(a & 0xffff0000u) - lam * __uint_as_float(c & 0xffff0000u);
            const float r = rsqrtf(wsum(v0 * v0 + v1 * v1, lane) * (1.f / 128.f) + EPS);
            oa[h] = pk2(v0 * r * g0, v1 * r * g1); }
#pragma unroll
        for (int h = 0; h < 8; ++h) {
            const float ga = __int_as_float(__builtin_amdgcn_readlane(__float_as_int(gl), h * 3)), gb = __int_as_float(__builtin_amdgcn_readlane(__float_as_int(gl), h * 3 + 1)), gc = __int_as_float(__builtin_amdgcn_readlane(__float_as_int(gl), h * 3 + 2));
            const unsigned a = oc[h], c = rs[h], e = rw[h];
            const float v0 = ga * __uint_as_float(a << 16) + gb * __uint_as_float(c << 16) + gc * __uint_as_float(e << 16);
            const float v1 = ga * __uint_as_float(a & 0xffff0000u) + gb * __uint_as_float(c & 0xffff0000u) + gc * __uint_as_float(e & 0xffff0000u);
            ob[h] = pk2(v0, v1); }
#pragma unroll
        for (int h = 0; h < 4; ++h) OA[(size_t)tok * 1024 + h * 64 + lane] = oa[h];
#pragma unroll
        for (int h = 0; h < 8; ++h) OA[(size_t)tok * 1024 + 256 + h * 64 + lane] = ob[h];
    }
}
#ifndef MK_SPLIT
#define MK_SPLIT 0
#endif
template <int MODE> __device__ __forceinline__ att::BlockRef att_ref(const Params& p, int idx) {
    constexpr int NBH = (MODE == att::M_FOX) ? 16 : 32, NH = NBH / 4;
    const int qb = 7 - idx / NBH, bh = idx % NBH, b = bh / NH, h = bh % NH;
    const att::bf16* P = (const att::bf16*)(p.ws + WS_P);
    const size_t tok0 = (size_t)b * SEQ + qb * 256, tokb = (size_t)b * SEQ;
    att::BlockRef r; r.P0 = qb * 256; r.cks = nullptr; r.sel = nullptr;
    if (MODE == att::M_DA) { r.Q = P + tok0 * LDP + PC_AQ + h * 64; r.K = P + tokb * LDP + PC_AK + h * 64; r.V = P + tokb * LDP + PC_AV + (h >> 1) * 128;
        r.O = (att::bf16*)(p.ws + WS_RDA) + tok0 * 1024 + h * 128; r.ldo = 1024; }
    else if (MODE == att::M_FOX) { r.Q = P + tok0 * LDP + PC_CQ + h * 128; r.K = P + tokb * LDP + PC_CK + h * 128; r.V = P + tokb * LDP + PC_CV + h * 128;
        r.O = (att::bf16*)(p.ws + WS_OA) + tok0 * 2048 + 1536 + h * 128; r.ldo = 2048; r.cks = (const float*)(p.ws + WS_CUMS) + (size_t)(b * 4 + h) * SEQ; }
    else if (MODE == att::M_SEL) { const int g = h >> 2; r.Q = P + tok0 * LDP + PC_BQ + h * 128; r.K = P + tokb * LDP + PC_BKV + 512 + g * 128; r.V = P + tokb * LDP + PC_BKV + 768 + g * 128;
        r.O = (att::bf16*)(p.ws + WS_RSEL) + tok0 * 1024 + h * 128; r.ldo = 1024; r.sel = (const unsigned*)(p.ws + WS_SELM) + (size_t)(b * 2 + g) * SEQ; }
    else { const int g = h >> 2; r.Q = P + tok0 * LDP + PC_BQ + h * 128; r.K = P + tokb * LDP + PC_BKV + 1024 + g * 128; r.V = P + tokb * LDP + PC_BKV + 1280 + g * 128;
        r.O = (att::bf16*)(p.ws + WS_RWIN) + tok0 * 1024 + h * 128; r.ldo = 1024; }
    return r;
}
__device__ __forceinline__ int q_fetch(unsigned* ctr, char* lds, int tid) {
    volatile __attribute__((address_space(3))) int* slot = (volatile __attribute__((address_space(3))) int*)((__attribute__((address_space(3))) char*)lds + LDS_SLOT);
    if (tid == 0) *slot = (int)atomicAdd(ctr, 1u);
    __syncthreads();
    const int v = *slot;
    return __builtin_amdgcn_readfirstlane(v);
}
template <int MODE> __device__ __forceinline__ void att_mode(const Params& p, unsigned* ctr, char* lds, int tid_in) {
    int tid = tid_in; asm volatile("" : "+v"(tid));
    constexpr int TOTAL = (MODE == att::M_FOX) ? 128 : 256;
    const int W = (MODE == att::M_WIN) ? 512 : (1 << 20);
    int idx = q_fetch(ctr, lds, tid);
    if (idx >= TOTAL) return;
    att::BlockRef cur = att_ref<MODE>(p, idx); att::Seam S;
    att::att_prime<MODE>(cur, W, lds, S, tid);
    for (;;) {
        const int nidx = q_fetch(ctr, lds, tid); const bool last = nidx >= TOTAL;
        const att::BlockRef nxt = last ? cur : att_ref<MODE>(p, nidx);
        att::att_block<MODE>(cur, nxt, SEQ, W, lds, S, tid);
        if (last) break;
        cur = nxt;
    }
}
#define LAS __attribute__((address_space(3)))
#define XB_TMO      128
#define XB_XCNT(j)  (256  + 64 * (j))
#define XB_XSUB(j)  (1280 + 64 * (j))
#define XB_XGEN(j)  (2304 + 64 * (j))
#define XB_TOP      3328
#define XB_TOPGEN   3392
#define XCD_BAR_WORDS 3456
#define XB_SPIN_CAP (1u << 18)

__device__ __forceinline__ unsigned xb_ld(unsigned* p)              { return __hip_atomic_load(p, __ATOMIC_RELAXED, __HIP_MEMORY_SCOPE_AGENT); }
__device__ __forceinline__ unsigned xb_add(unsigned* p, unsigned v) { return __hip_atomic_fetch_add(p, v, __ATOMIC_RELAXED, __HIP_MEMORY_SCOPE_AGENT); }
__device__ __forceinline__ unsigned xb_xcc_id() { return (unsigned)__builtin_amdgcn_s_getreg((3 << 11) | 20) & 0xFu; }
#define XB_SPIN(cond, bar) do { unsigned _sp = 0; while (cond) { __builtin_amdgcn_s_sleep(1); \
    if ((++_sp & 255u) == 0u) { if (xb_ld(&(bar)[XB_TMO])) break; if (_sp > XB_SPIN_CAP) { atomicAdd(&(bar)[XB_TMO], 1u); break; } } } } while (0)

struct XcdBarrier {
    unsigned* bar; unsigned x;
    volatile LAS unsigned* st;
};

__device__ __forceinline__ XcdBarrier xcd_barrier_post(unsigned* bar, volatile LAS unsigned* st) {
    XcdBarrier b; b.bar = bar; b.x = xb_xcc_id(); b.st = st;
    if (threadIdx.x == 0) (void)xb_add(&bar[XB_XCNT(b.x)], 1u);
    return b;
}
__device__ __forceinline__ void xcd_barrier_complete(unsigned* bar, unsigned x, unsigned& nloc, unsigned& nx) {
    const unsigned G = gridDim.x * gridDim.y * gridDim.z;
    unsigned sum, cnt, mine, sp = 0u;
    for (;;) {
        sum = 0u; cnt = 0u; mine = 0u;
#pragma unroll
        for (unsigned j = 0; j < 16; ++j) { const unsigned c = xb_ld(&bar[XB_XCNT(j)]); sum += c; cnt += (c > 0u) ? 1u : 0u; mine = (j == x) ? c : mine; }
        if (sum == G) break;
        __builtin_amdgcn_s_sleep(1);
        if ((++sp & 255u) == 0u) { if (xb_ld(&bar[XB_TMO])) break; if (sp > XB_SPIN_CAP) { atomicAdd(&bar[XB_TMO], 1u); break; } }
    }
    nloc = mine > 0u ? mine : 1u; nx = cnt > 0u ? cnt : 1u;
}

__device__ __forceinline__ void xcd_barrier(const XcdBarrier& b) {
    asm volatile("s_waitcnt vmcnt(0)" ::: "memory");
    __syncthreads();
    if (threadIdx.x == 0) {
        unsigned* bar = b.bar;
        __builtin_amdgcn_s_waitcnt(0);
        unsigned nloc = b.st[0], nx = b.st[1];
        if (nloc == 0u) { xcd_barrier_complete(bar, b.x, nloc, nx); b.st[0] = nloc; b.st[1] = nx; }
        const unsigned old = xb_add(&bar[XB_XSUB(b.x)], 1u);
        const unsigned gen = old / nloc;
        if (old + 1u == (gen + 1u) * nloc) {
            __builtin_amdgcn_fence(__ATOMIC_RELEASE, "agent");
            asm volatile("s_waitcnt vmcnt(0)" ::: "memory");
            const unsigned og = xb_add(&bar[XB_TOP], 1u);
            const unsigned tg = og / nx;
            if (og + 1u == (tg + 1u) * nx) xb_add(&bar[XB_TOPGEN], 1u);
            else XB_SPIN(xb_ld(&bar[XB_TOPGEN]) == tg, bar);
            __builtin_amdgcn_fence(__ATOMIC_ACQUIRE, "agent");
            xb_add(&bar[XB_XGEN(b.x)], 1u);
            asm volatile("s_waitcnt vmcnt(0)" ::: "memory");
        } else {
            XB_SPIN(xb_ld(&bar[XB_XGEN(b.x)]) == gen, bar);
            __builtin_amdgcn_fence(__ATOMIC_ACQUIRE, "agent");
            asm volatile("s_waitcnt vmcnt(0)" ::: "memory");
        }
    }
    __syncthreads();
}

constexpr int CW_BAR = 4096;
constexpr int LDS_BARST = 140032;
constexpr int PH_PER_LAYER = 13, N_PHASES = PH_PER_LAYER * DEPTH;
typedef const Params __attribute__((address_space(4)))* KP;
template <int KS> __device__ __forceinline__ void phase_body(const int ph, char* lds, pg8::PG8_LAS_T ldsg, const int wave_s, const XcdBarrier& bar, const int rep) {
        KP kp = (KP)__builtin_amdgcn_kernarg_segment_ptr(); asm volatile("" : "+s"(kp));
        const Params& p = *(const Params*)kp;
        int bid = blockIdx.x; asm volatile("" : "+s"(bid));
        int G = gridDim.x; asm volatile("" : "+s"(G)); const int NGW = G * NWAVES;
        unsigned char* ws = p.ws;
        unsigned* ctl = (unsigned*)(ws + WS_CTL);
        bf16r* H = (bf16r*)(ws + WS_H); bf16r* P = (bf16r*)(ws + WS_P); bf16r* ACT = (bf16r*)(ws + WS_P);
        const int layer = ph / PH_PER_LAYER, k = ph - layer * PH_PER_LAYER;
        int tid; asm volatile("v_mbcnt_lo_u32_b32 %0, -1, 0\n\tv_mbcnt_hi_u32_b32 %0, -1, %0" : "=v"(tid)); tid += wave_s * 64;
        const int lane = tid & 63, wave = __builtin_amdgcn_readfirstlane(tid >> 6), gw = bid * NWAVES + wave;
        const float* xin = (layer == 0) ? p.in[0] : p.out;
        {
        if constexpr (KS < 0 || KS == 0) if (k == 0) {
            if (ph == 0) { if (bid == 0 && tid < 32) ctl[64 * tid] = 0u;
                unsigned long long* rz = (unsigned long long*)(ws + WS_RS) + T; for (int i = bid * NTHR + tid; i < 6 * T; i += G * NTHR) rz[i] = 0ull;
                phase_rms(xin, p.in[2], H, (unsigned long long*)(ws + WS_RS), gw, NGW, lane); }
            phase_convert(p, layer, lds, gw, NGW, wave, lane);
        }
        if constexpr (KS < 0 || KS == 1 || KS == 11) if (k == 1 || k == 11) {
            pg8::Gemm g{H, (const bf16r*)(ws + (k == 1 ? WS_WGU1 : WS_WGU2)), T, 2 * FF, DM}; pg8::StaticOrder S; S.init(T, 2 * FF, G, bid);
            pg8::EpiGU E{ACT, FF, (const unsigned long long*)(ws + WS_RS) + (size_t)(layer * 3 + (k == 1 ? 0 : 2)) * T};
            pg8::gemm_phase<pg8::EpiGU, pg8::StaticOrder, true, true>(ldsg, g, S, E, tid);
        }
        if constexpr (KS < 0 || KS == 2 || KS == 12 || KS == 10) if (k == 2 || k == 12 || k == 10) {
            const bf16r* A = (k == 10) ? (const bf16r*)(ws + WS_YBF) : ACT; const bf16r* B = (const bf16r*)(ws + (k == 2 ? WS_WD1 : (k == 12 ? WS_WD2 : WS_WO)));
            pg8::Gemm g{A, B, T, DM, (k == 10) ? DM : FF}; pg8::StaticOrder S; S.init(T, DM, G, bid);
            const int nl = (layer + 1 < DEPTH) ? layer + 1 : layer;
            const float* gn = (k == 2) ? p.in[6] + layer * DM : (k == 10 ? p.in[24] + layer * DM : p.in[2] + nl * DM);
            unsigned long long* rsn = (unsigned long long*)(ws + WS_RS) + (size_t)(k == 2 ? layer * 3 + 1 : (k == 10 ? layer * 3 + 2 : layer * 3 + 3)) * T;
            if (k == 10) { pg8::EpiRes<0> E{(const float*)p.out, p.out, gn, H, rsn}; pg8::gemm_phase<pg8::EpiRes<0>, pg8::StaticOrder, true, true>(ldsg, g, S, E, tid); }
            else { pg8::EpiRes<1> E{(k == 2) ? xin : (const float*)p.out, p.out, gn, H, rsn}; pg8::gemm_phase<pg8::EpiRes<1>, pg8::StaticOrder, true, true>(ldsg, g, S, E, tid); }
        }
        if constexpr (KS < 0 || KS == 3) if (k == 3) {
            pg8::Gemm g{H, (const bf16r*)(ws + WS_WIN), T, LDP, DM}; pg8::StaticOrder S; S.init(T, LDP, G, bid);
            pg8::EpiP E{P, LDP, (const unsigned long long*)(ws + WS_RS) + (size_t)(layer * 3 + 1) * T};
            pg8::gemm_phase<pg8::EpiP, pg8::StaticOrder, true, true>(ldsg, g, S, E, tid);
        }
        if constexpr (KS < 0 || KS == 4) if (k == 4) { phase_prep(p, layer, gw, NGW, lane); }
        if constexpr (KS < 0 || KS == 5) if (k == 5) { phase_cmp1(p, layer, gw, NGW, lane); }
        if constexpr (KS < 0 || KS == 6) if (k == 6) { phase_cmp2(p, layer, lds, gw, NGW, wave, lane); }
        if constexpr (KS < 0 || KS == 7) if (k == 7) { phase_cmpattn(p, lds, bid, G, tid, wave, lane); }
        if constexpr (KS < 0 || KS == 8) if (k == 8) {
            unsigned* c = ctl + 64 * (layer * 4 + rep * 8);

#ifndef ATTMASK
#define ATTMASK 15
#endif
#ifndef PROBE_ATT
#define PROBE_ATT 15
#endif
#if ATTMASK & 1
            if (rep == 0 || (PROBE_ATT & 1)) att_mode<att::M_DA>(p, c, lds, tid);
#endif
#if ATTMASK & 2
            if (rep == 0 || (PROBE_ATT & 2)) att_mode<att::M_SEL>(p, c + 64, lds, tid);
#endif
#if ATTMASK & 4
            if (rep == 0 || (PROBE_ATT & 4)) att_mode<att::M_FOX>(p, c + 128, lds, tid);
#endif
#if ATTMASK & 8
            if (rep == 0 || (PROBE_ATT & 8)) att_mode<att::M_WIN>(p, c + 192, lds, tid);
#endif

        }
        if constexpr (KS < 0 || KS == 9) if (k == 9) {
#ifndef MM
#define MM 15
#endif
#if MM & 1
            phase_combine(p, layer, gw, NGW, lane);
            xcd_barrier(bar);
#endif
            pg8::StaticOrder S; S.init(T, DM, G, bid);
            { pg8::Gemm g{(const bf16r*)(ws + WS_OA), (const bf16r*)(ws + WS_WA), T, DM, DM}; pg8::EpiMergeH E{P, LDP, PC_GM, (bf16r*)(ws + WS_YBF), DM};
              pg8::gemm_phase<pg8::EpiMergeH, pg8::StaticOrder, true, true>(ldsg, g, S, E, tid); }
        }
        }
}
template <int KS, int PH> struct Runner {
    static __device__ __forceinline__ void run(char* lds, pg8::PG8_LAS_T ldsg, const int wave_s, cg::grid_group& grid, const XcdBarrier& bar) {
        phase_body<KS>(PH, lds, ldsg, wave_s, bar, 0);
#ifdef PROBE_PH
        if constexpr (PH == PROBE_PH) { xcd_barrier(bar); phase_body<KS>(PH, lds, ldsg, wave_s, bar, 1); }
#endif
#ifdef PROBE_DUP
        if constexpr ((PROBE_DUP >> (PH % PH_PER_LAYER)) & 1) { xcd_barrier(bar); phase_body<KS>(PH, lds, ldsg, wave_s, bar, 1); }
#endif
        if constexpr (PH + 1 < N_PHASES) {
            xcd_barrier(bar);
            Runner<KS, PH + 1>::run(lds, ldsg, wave_s, grid, bar); }
    }
};
template <int KS> __global__ void __launch_bounds__(NTHR, 2) mega_fwd(Params p_arg) {
    extern __shared__ __attribute__((aligned(16))) unsigned char lds_raw[];
    char* lds = (char*)lds_raw;
    pg8::PG8_LAS_T ldsg = (pg8::PG8_LAS_T)lds_raw;
    cg::grid_group grid = cg::this_grid();
    const int wave_s = __builtin_amdgcn_readfirstlane(threadIdx.x >> 6);
    volatile LAS unsigned* st = (volatile LAS unsigned*)((LAS unsigned char*)lds_raw + LDS_BARST);
    if (threadIdx.x < 2) st[threadIdx.x] = 0u;
    __syncthreads();
    const XcdBarrier bar = xcd_barrier_post((unsigned*)(p_arg.ws + WS_CTL) + CW_BAR, st);
    if constexpr (KS < 0) { if (p_arg.ph_hi < 0) grid.sync();
        Runner<KS, 0>::run(lds, ldsg, wave_s, grid, bar); }
    else { const int ph_lo = p_arg.ph_lo, ph_hi = p_arg.ph_hi;
        for (int ph = ph_lo; ph < ph_hi; ++ph) { phase_body<KS>(ph, lds, ldsg, wave_s, bar, 0); if (ph + 1 < ph_hi) grid.sync(); } }
}
template <int KS> static const void* kfn() { return (const void*)mega_fwd<KS>; }
static const void* kfn_of(int k) {
#if MK_SPLIT
    switch (k) { case 0: return kfn<0>(); case 1: case 11: return kfn<1>(); case 2: case 12: case 10: return kfn<2>(); case 3: return kfn<3>();
        case 4: return kfn<4>(); case 5: return kfn<5>(); case 6: return kfn<6>(); case 7: return kfn<7>(); case 8: return kfn<8>(); default: return kfn<9>(); }
#else
    (void)k; return kfn<-1>();
#endif
}
extern "C" void kernel_launch(void* const* d_in, const int* in_sizes, int n_in, void* d_out, int out_size, void* d_ws, size_t ws_size, hipStream_t stream) {
    static int grid = 0;
    if (grid == 0) {
        if (n_in != 28 || out_size != T * DM || ws_size < WS_END) { fprintf(stderr, "kernel_launch: unexpected shapes (n_in %d out %d ws %zu need %zu)\n", n_in, out_size, ws_size, (size_t)WS_END); grid = -1; return; }
        int dev = 0, cus = 0;
        (void)hipGetDevice(&dev); (void)hipDeviceGetAttribute(&cus, hipDeviceAttributeMultiprocessorCount, dev);
        for (int k = 0; k < PH_PER_LAYER; ++k)
            if (hipFuncSetAttribute(kfn_of(k), hipFuncAttributeMaxDynamicSharedMemorySize, LDS_BYTES) != hipSuccess) { fprintf(stderr, "hipFuncSetAttribute failed\n"); grid = -1; return; }
        int per_cu = 0;
        if (hipOccupancyMaxActiveBlocksPerMultiprocessor(&per_cu, kfn_of(8), NTHR, LDS_BYTES) != hipSuccess || per_cu < 1) fprintf(stderr, "occupancy query: %d\n", per_cu);
        (void)hipGetLastError();
        grid = cus > 0 ? cus : 256;
    }
    if (grid < 0) return;
    if (hipMemsetAsync(d_ws, 0, 65536, stream) != hipSuccess) { fprintf(stderr, "memset failed\n"); return; }
    Params p{};
    for (int i = 0; i < 28; ++i) p.in[i] = (const float*)d_in[i];
    p.out = (float*)d_out; p.ws = (unsigned char*)d_ws;
#if MK_SPLIT
    for (int ph = 0; ph < N_PHASES; ++ph) { p.ph_lo = ph; p.ph_hi = ph + 1; void* args[] = {&p};
        hipError_t e = hipLaunchCooperativeKernel(kfn_of(ph % PH_PER_LAYER), dim3(grid), dim3(NTHR), args, LDS_BYTES, stream);
        if (e != hipSuccess) { fprintf(stderr, "launch %d failed: %s\n", ph, hipGetErrorString(e)); break; } }
#else
    p.ph_lo = 0; p.ph_hi = N_PHASES; void* args[] = {&p};
    hipError_t e = hipLaunchCooperativeKernel(kfn_of(0), dim3(grid), dim3(NTHR), args, LDS_BYTES, stream);
    if (e != hipSuccess) fprintf(stderr, "cooperative launch failed: %s (grid %d)\n", hipGetErrorString(e), grid);
#endif
}
```
